# Optimizing an MI355X kernel written in HIP

```python
import math
import jax, jax.numpy as jnp
from jax import lax
import numpy as np

D_MODEL = 1024
BATCH = 2
SEQ = 16384
DEPTH = 1

N_META = 16
D_MIX = D_MODEL
EPS = 1e-6
MLA_HEADS = 8
QK_NOPE = 64
QK_ROPE = 32
V_HEAD = 64
Q_LORA = 256
KV_LORA = 128
D_ATTN = MLA_HEADS * V_HEAD
ROPE_THETA = 10000.0
Q_BLOCK = 128
D_SSM = D_MIX - D_ATTN
SSM_GROUP = 16
N_SSM_GROUPS = D_SSM // SSM_GROUP
SSM_STATE = 64
DT_MIN = 1e-3
DT_MAX = 1e-1
IN_SPLITS = (Q_LORA, KV_LORA, QK_ROPE, D_ATTN, D_SSM, D_SSM)
D_IN = sum(IN_SPLITS)

kernel_name = "hymba_mla_s5_bidir_block"


def rmsnorm(x, w):
    xf = x.astype(jnp.float32)
    y = xf * lax.rsqrt(jnp.mean(xf * xf, axis=-1, keepdims=True) + EPS)
    return (y * w.astype(jnp.float32)).astype(x.dtype)


def rope(x, pos):
    d = x.shape[-1]
    half = d // 2
    inv = ROPE_THETA ** (-jnp.arange(half, dtype=jnp.float32) / half)
    ang = pos.astype(jnp.float32)[:, None] * inv[None, :]
    cos = jnp.cos(ang)[None, :, None, :]
    sin = jnp.sin(ang)[None, :, None, :]
    xf = x.astype(jnp.float32)
    x1, x2 = xf[..., :half], xf[..., half:]
    out = jnp.concatenate([x1 * cos - x2 * sin, x1 * sin + x2 * cos], axis=-1)
    return out.astype(x.dtype)


def block_attention(q, k, v):
    b, h, L, dqk = q.shape
    dv = v.shape[-1]
    n_blk = -(-L // Q_BLOCK)
    pad = n_blk * Q_BLOCK - L
    qp = jnp.pad(q, ((0, 0), (0, 0), (0, pad), (0, 0)))
    qb = qp.reshape(b, h, n_blk, Q_BLOCK, dqk).transpose(2, 0, 1, 3, 4)
    scale = 1.0 / math.sqrt(dqk)

    def one_block(qblk):
        s = jnp.einsum('bhqd,bhkd->bhqk', qblk, k).astype(jnp.float32) * scale
        p = jax.nn.softmax(s, axis=-1)
        return jnp.einsum('bhqk,bhkd->bhqd', p.astype(v.dtype), v)

    out = lax.map(one_block, qb)
    out = out.transpose(1, 0, 3, 2, 4).reshape(b, n_blk * Q_BLOCK, h * dv)
    return out[:, :L]


def s5_direction(u, a_re, a_im, log_dt, b_re, b_im, c_re, c_im, reverse):
    dt = jnp.exp(log_dt.astype(jnp.float32))[:, None]
    a_re = a_re.astype(jnp.float32)
    a_im = a_im.astype(jnp.float32)
    mag = jnp.exp(a_re * dt)
    abar_re = mag * jnp.cos(a_im * dt)
    abar_im = mag * jnp.sin(a_im * dt)
    num_re = abar_re - 1.0
    num_im = abar_im
    den = a_re * a_re + a_im * a_im
    coef_re = (num_re * a_re + num_im * a_im) / den
    coef_im = (num_im * a_re - num_re * a_im) / den
    b_re = b_re.astype(jnp.float32)
    b_im = b_im.astype(jnp.float32)
    bbar_re = coef_re[..., None] * b_re - coef_im[..., None] * b_im
    bbar_im = coef_re[..., None] * b_im + coef_im[..., None] * b_re
    bu_re = jnp.einsum('blgh,gph->blgp', u, bbar_re)
    bu_im = jnp.einsum('blgh,gph->blgp', u, bbar_im)
    L = u.shape[1]
    g, p = abar_re.shape
    as_re = jnp.broadcast_to(abar_re[None, None], (1, L, g, p))
    as_im = jnp.broadcast_to(abar_im[None, None], (1, L, g, p))

    def combine(left, right):
        ar1, ai1, br1, bi1 = left
        ar2, ai2, br2, bi2 = right
        ar = ar2 * ar1 - ai2 * ai1
        ai = ar2 * ai1 + ai2 * ar1
        br = ar2 * br1 - ai2 * bi1 + br2
        bi = ar2 * bi1 + ai2 * br1 + bi2
        return (ar, ai, br, bi)

    _, _, x_re, x_im = lax.associative_scan(
        combine, (as_re, as_im, bu_re, bu_im), axis=1, reverse=reverse)
    return (jnp.einsum('blgp,ghp->blgh', x_re, c_re.astype(jnp.float32))
            - jnp.einsum('blgp,ghp->blgh', x_im, c_im.astype(jnp.float32)))


def hybrid_layer(h, pos, pre_norm_w, post_norm_w, w_in, q_norm_w, w_q_up, kv_norm_w,
                 w_kv_up, attn_out_norm_w, ssm_a_re, ssm_a_im, ssm_log_dt, ssm_b_re,
                 ssm_b_im, ssm_c_re, ssm_c_im, ssm_d, w_glu, b_glu, ssm_out_norm_w, w_out):
    b, L, _ = h.shape
    xn = rmsnorm(h, pre_norm_w)
    proj = jnp.einsum('bld,de->ble', xn, w_in)
    offs = np.cumsum(IN_SPLITS)[:-1].tolist()
    q_lat, kv_lat, k_rope, attn_gate, ssm_u, ssm_gate = jnp.split(proj, offs, axis=-1)

    q = jnp.einsum('blr,re->ble', rmsnorm(q_lat, q_norm_w), w_q_up)
    q = q.reshape(b, L, MLA_HEADS, QK_NOPE + QK_ROPE)
    q_nope, q_rope = q[..., :QK_NOPE], rope(q[..., QK_NOPE:], pos)
    kv = jnp.einsum('blr,re->ble', rmsnorm(kv_lat, kv_norm_w), w_kv_up)
    kv = kv.reshape(b, L, MLA_HEADS, QK_NOPE + V_HEAD)
    k_nope, v = kv[..., :QK_NOPE], kv[..., QK_NOPE:]
    k_r = rope(k_rope[:, :, None, :], pos)
    k_r = jnp.broadcast_to(k_r, (b, L, MLA_HEADS, QK_ROPE))
    qf = jnp.concatenate([q_nope, q_rope], axis=-1).transpose(0, 2, 1, 3)
    kf = jnp.concatenate([k_nope, k_r], axis=-1).transpose(0, 2, 1, 3)
    vf = v.transpose(0, 2, 1, 3)
    y_attn = block_attention(qf, kf, vf)
    y_attn = rmsnorm(y_attn * jax.nn.silu(attn_gate), attn_out_norm_w)

    u = ssm_u.astype(jnp.float32).reshape(b, L, N_SSM_GROUPS, SSM_GROUP)
    y_f = s5_direction(u, ssm_a_re[0], ssm_a_im[0], ssm_log_dt[0], ssm_b_re[0],
                       ssm_b_im[0], ssm_c_re[0], ssm_c_im[0], reverse=False)
    y_b = s5_direction(u, ssm_a_re[1], ssm_a_im[1], ssm_log_dt[1], ssm_b_re[1],
                       ssm_b_im[1], ssm_c_re[1], ssm_c_im[1], reverse=True)
    y_ssm = (y_f + y_b).reshape(b, L, D_SSM) + ssm_d.astype(jnp.float32) * ssm_u.astype(jnp.float32)
    y_ssm = jax.nn.gelu(y_ssm).astype(h.dtype)
    glu = jnp.einsum('ble,ef->blf', y_ssm, w_glu) + b_glu
    y_ssm = glu[..., :D_SSM] * jax.nn.sigmoid(glu[..., D_SSM:])
    y_ssm = rmsnorm(y_ssm * jax.nn.silu(ssm_gate), ssm_out_norm_w)

    y = jnp.concatenate([y_attn, y_ssm], axis=-1)
    y = jnp.einsum('ble,ed->bld', y, w_out)
    return h + rmsnorm(y, post_norm_w)


def setup_inputs(seed: int = 0) -> dict:
    key = jax.random.key(seed)
    ks = jax.random.split(key, 24)
    f32 = jnp.float32

    def nrm(k, shape, fan_in):
        return jax.random.normal(k, shape, f32) * (fan_in ** -0.5)

    def gain(k, shape):
        return 1.0 + 0.02 * jax.random.normal(k, shape, f32)

    G, P, H = N_SSM_GROUPS, SSM_STATE, SSM_GROUP
    a_re = -0.5 + 0.01 * jax.random.normal(ks[10], (DEPTH, 2, G, P), f32)
    a_im = (jnp.pi * jnp.arange(P, dtype=f32))[None, None, None, :] \
        + 0.01 * jax.random.normal(ks[11], (DEPTH, 2, G, P), f32)
    log_dt = jax.random.uniform(ks[12], (DEPTH, 2, G), f32,
                                minval=math.log(DT_MIN), maxval=math.log(DT_MAX))
    return {
        "x": jax.random.normal(ks[0], (BATCH, SEQ, D_MODEL), f32),
        "meta_tokens": jax.random.normal(ks[1], (N_META, D_MODEL), f32),
        "pre_norm_w": gain(ks[2], (DEPTH, D_MODEL)),
        "post_norm_w": gain(ks[3], (DEPTH, D_MODEL)),
        "w_in": nrm(ks[4], (DEPTH, D_MODEL, D_IN), D_MODEL),
        "q_norm_w": gain(ks[5], (DEPTH, Q_LORA)),
        "w_q_up": nrm(ks[6], (DEPTH, Q_LORA, MLA_HEADS * (QK_NOPE + QK_ROPE)), Q_LORA),
        "kv_norm_w": gain(ks[7], (DEPTH, KV_LORA)),
        "w_kv_up": nrm(ks[8], (DEPTH, KV_LORA, MLA_HEADS * (QK_NOPE + V_HEAD)), KV_LORA),
        "attn_out_norm_w": gain(ks[9], (DEPTH, D_ATTN)),
        "ssm_a_re": a_re,
        "ssm_a_im": a_im,
        "ssm_log_dt": log_dt,
        "ssm_b_re": nrm(ks[13], (DEPTH, 2, G, P, H), 2 * H),
        "ssm_b_im": nrm(ks[14], (DEPTH, 2, G, P, H), 2 * H),
        "ssm_c_re": nrm(ks[15], (DEPTH, 2, G, H, P), 2 * P),
        "ssm_c_im": nrm(ks[16], (DEPTH, 2, G, H, P), 2 * P),
        "ssm_d": jax.random.normal(ks[17], (DEPTH, D_SSM), f32),
        "w_glu": nrm(ks[18], (DEPTH, D_SSM, 2 * D_SSM), D_SSM),
        "b_glu": 0.01 * jax.random.normal(ks[19], (DEPTH, 2 * D_SSM), f32),
        "ssm_out_norm_w": gain(ks[20], (DEPTH, D_SSM)),
        "w_out": nrm(ks[21], (DEPTH, D_MIX, D_MODEL), D_MIX),
    }


def reference(x, meta_tokens, pre_norm_w, post_norm_w, w_in, q_norm_w, w_q_up, kv_norm_w,
              w_kv_up, attn_out_norm_w, ssm_a_re, ssm_a_im, ssm_log_dt, ssm_b_re, ssm_b_im,
              ssm_c_re, ssm_c_im, ssm_d, w_glu, b_glu, ssm_out_norm_w, w_out):
    b = x.shape[0]
    meta = jnp.broadcast_to(meta_tokens[None].astype(x.dtype), (b, N_META, x.shape[-1]))
    h = jnp.concatenate([meta, x], axis=1)
    pos = jnp.arange(h.shape[1], dtype=jnp.int32)
    for i in range(DEPTH):
        h = hybrid_layer(h, pos, pre_norm_w[i], post_norm_w[i], w_in[i], q_norm_w[i],
                         w_q_up[i], kv_norm_w[i], w_kv_up[i], attn_out_norm_w[i],
                         ssm_a_re[i], ssm_a_im[i], ssm_log_dt[i], ssm_b_re[i], ssm_b_im[i],
                         ssm_c_re[i], ssm_c_im[i], ssm_d[i], w_glu[i], b_glu[i],
                         ssm_out_norm_w[i], w_out[i])
    return h[:, N_META:]
```

```cpp
#include <hip/hip_runtime.h>
#include <hip/hip_bf16.h>
#include <hip/hip_cooperative_groups.h>
#include <cstdio>
namespace cg = cooperative_groups;
#include <stdint.h>
typedef __hip_bfloat16 bf16;
#ifndef REP_ATTN
#define REP_ATTN 1
#endif
#ifndef REP_INPROJ
#define REP_INPROJ 1
#endif
#ifndef REP_TAIL
#define REP_TAIL 1
#endif
#ifndef REP_P2
#define REP_P2 1
#endif
#ifndef REP_GLU
#define REP_GLU 1
#endif
#ifndef REP_OUT
#define REP_OUT 1
#endif
#ifndef REP_FIN
#define REP_FIN 1
#endif
#ifndef REP_SYNC
#define REP_SYNC 1
#endif

constexpr int DM = 1024, SEQ = 16384, NB = 2, NMETA = 16, LTOT = SEQ + NMETA;
constexpr int DIN = 1952, QL = 256, KVL = 128, QR = 32, DA = 512, DS = 512;
constexpr int NH = 8, DQK = 96, DV = 64, NG = 32, GH = 16, NP = 64;
constexpr int RX = NB * SEQ;
constexpr int RT = RX + NMETA;
constexpr int RP = 33024;
constexpr int KPAD = 48;
constexpr int NKEY = LTOT + KPAD;
constexpr float EPS = 1e-6f;
constexpr int LDK = DM + 64;

constexpr size_t al(size_t x) { return (x + 255) / 256 * 256; }
constexpr size_t O_WTIN = 0;
constexpr size_t O_WTQ = O_WTIN + al((size_t)DIN * LDK * 2);
constexpr size_t O_WTKV = O_WTQ + al((size_t)768 * QL * 2);
constexpr size_t O_WTGLU = O_WTKV + al((size_t)1024 * KVL * 2);
constexpr size_t O_WTOUT = O_WTGLU + al((size_t)1024 * DS * 2);
constexpr size_t O_BGLU = O_WTOUT + al((size_t)DM * DM * 2);
constexpr size_t O_ROPE = O_BGLU + al(1024 * 4);
constexpr size_t O_ABAR = O_ROPE + al((size_t)LTOT * 16 * 8);
constexpr size_t O_BBAR = O_ABAR + al(2 * 32 * 64 * 8);
constexpr size_t O_QLAT = O_BBAR + al(2 * 32 * 64 * 16 * 8);
constexpr size_t O_KVLAT = O_QLAT + al((size_t)RP * QL * 2);
constexpr size_t O_AGATE = O_KVLAT + al((size_t)RP * KVL * 2);
constexpr size_t O_SGATE = O_AGATE + al((size_t)RX * DA * 2);
constexpr size_t O_SUG = O_SGATE + al((size_t)RX * DS * 2);
constexpr size_t O_KN = O_SUG + al((size_t)NG * RP * GH * 2);
constexpr size_t O_V = O_KN + al((size_t)NB * NH * NKEY * 64 * 2);
constexpr size_t O_KR = O_V + al((size_t)NB * NH * NKEY * 64 * 2);
constexpr size_t O_Q = O_KR + al((size_t)NB * NKEY * 32 * 2);
constexpr size_t O_YA = O_Q + al((size_t)NB * NH * SEQ * DQK * 2);
constexpr size_t O_YSG = O_YA + al((size_t)RX * DA * 2);
constexpr size_t O_YSN = O_YSG + al((size_t)RX * DS * 2);
constexpr size_t O_RSX = O_YSN + al((size_t)RX * DS * 2);
constexpr size_t O_RSQ = O_RSX + al(RP * 4);
constexpr size_t O_RSKV = O_RSQ + al(RP * 4);
constexpr size_t O_RSA = O_RSKV + al(RP * 4);
constexpr size_t O_PW = O_RSA + al(RP * 4);
constexpr size_t O_KT = O_PW + al(2 * 32 * 64 * 17 * 8);
constexpr size_t O_WS = O_KT + al(2 * 32 * 16 * 256 * 4);
constexpr size_t O_MSG = O_WS + al((size_t)32 * 256 * 256 * 2);
constexpr size_t O_S = O_MSG + al((size_t)32 * 256 * 512 * 2);
constexpr size_t O_XB = O_S;
constexpr size_t O_E = O_S + al((size_t)RP * LDK * 2);
constexpr size_t O_XA = O_E + al((size_t)2 * 32 * 2 * 32 * 64 * 8);
constexpr size_t O_BAR = O_XA + al((size_t)32 * 2048 * 256 * 2);
constexpr size_t O_GPART = O_BAR + al(4096 * 4);
constexpr size_t O_YPART = O_GPART + al((size_t)16 * RX * 4);
constexpr size_t O_Y = O_S;
constexpr size_t O_END = O_YPART + al((size_t)16 * RX * 4);

struct P {
  const float *x, *meta, *pre_w, *post_w, *w_in, *qn_w, *w_qup, *kvn_w, *w_kvup, *aon_w;
  const float *a_re, *a_im, *log_dt, *b_re, *b_im, *c_re, *c_im, *ssm_d, *w_glu, *b_glu, *son_w, *w_out;
  float* out; char* ws;
};
#define WSP(T, off) ((T*)(p.ws + (off)))

__device__ __forceinline__ float bf2f(bf16 v) { return __bfloat162float(v); }
__device__ __forceinline__ bf16 f2bf(float v) { return __float2bfloat16(v); }
__device__ __forceinline__ float silu(float v) { return v / (1.f + __expf(-v)); }
__device__ __forceinline__ float gelu_tanh(float v) {
  const float u = 0.7978845608028654f * (v + 0.044715f * v * v * v);
  return v / (1.f + __expf(-2.f * u));
}
__device__ __forceinline__ const float* xrow(const P& p, int r) {
  return r < RX ? p.x + (size_t)r * DM : p.meta + (size_t)(r - RX) * DM;
}
__device__ __forceinline__ void sincos_red(double ang, float& c, float& s) {
  const double TWO_PI = 6.283185307179586476925;
  double n = rint(ang / TWO_PI); float r = (float)(ang - n * TWO_PI);
  c = cosf(r); s = sinf(r);
}

using bf16x8 = __attribute__((ext_vector_type(8))) short;
using f32x16 = __attribute__((ext_vector_type(16))) float;
using f32x4v = __attribute__((ext_vector_type(4))) float;
using u32x4 = __attribute__((ext_vector_type(4))) unsigned;
__device__ __forceinline__ int otid() { int t = threadIdx.x; asm volatile("" : "+v"(t)); return t; }
__device__ __forceinline__ int crow(int r, int hi) { return (r & 3) + 8 * (r >> 2) + 4 * hi; }
__device__ __forceinline__ unsigned cvtpk(float lo, float hi) { unsigned r; asm("v_cvt_pk_bf16_f32 %0, %1, %2" : "=v"(r) : "v"(lo), "v"(hi)); return r; }
__device__ __forceinline__ float bflo(unsigned u) { return __uint_as_float(u << 16); }
__device__ __forceinline__ float bfhi(unsigned u) { return __uint_as_float(u & 0xffff0000u); }
__device__ __forceinline__ void stbf(bf16* dst, float v) { *(unsigned short*)dst = (unsigned short)(cvtpk(v, v) & 0xffffu); }

__device__ __forceinline__ void prep_transposes(const P& p, char* lds) {
  float* T = (float*)lds; const int tid = threadIdx.x;
  constexpr int T_IN = 16 * 31, T_OUT = 16 * 16, T_GLU = 8 * 16, T_Q = 4 * 12, T_KV = 2 * 16, T_ALL = T_IN + T_OUT + T_GLU + T_Q + T_KV;
  for (int t = blockIdx.x; t < T_ALL; t += gridDim.x) {
    const float* W; const float* g0; const float* g1 = nullptr; bf16* dst; int N, ldk, kt, nt_, which;
    if (t < T_IN) { which = 0; W = p.w_in; g0 = p.pre_w; dst = WSP(bf16, O_WTIN); N = DIN; ldk = LDK; kt = t / 31; nt_ = t % 31; }
    else if (t < T_IN + T_OUT) { const int u = t - T_IN; which = 1; W = p.w_out; g0 = p.aon_w; g1 = p.son_w; dst = WSP(bf16, O_WTOUT); N = DM; ldk = DM; kt = u >> 4; nt_ = u & 15; }
    else if (t < T_IN + T_OUT + T_GLU) { const int u = t - T_IN - T_OUT; which = 2; W = p.w_glu; g0 = nullptr; dst = WSP(bf16, O_WTGLU); N = 1024; ldk = DS; kt = u >> 4; nt_ = u & 15; }
    else if (t < T_IN + T_OUT + T_GLU + T_Q) { const int u = t - T_IN - T_OUT - T_GLU; which = 3; W = p.w_qup; g0 = p.qn_w; dst = WSP(bf16, O_WTQ); N = 768; ldk = QL; kt = u / 12; nt_ = u % 12; }
    else { const int u = t - T_IN - T_OUT - T_GLU - T_Q; which = 4; W = p.w_kvup; g0 = p.kvn_w; dst = WSP(bf16, O_WTKV); N = 1024; ldk = KVL; kt = u >> 4; nt_ = u & 15; }
    const int k0 = kt * 64, n0 = nt_ * 64;
#pragma unroll
    for (int i = 0; i < 8; ++i) { const int kk = (tid >> 6) + 8 * i, nn = tid & 63, k = k0 + kk, n = n0 + nn;
      float gk = 1.f; if (which == 1) gk = k < 512 ? g0[k] : g1[k - 512]; else if (g0) gk = g0[k];
      T[kk * 65 + nn] = (n < N) ? W[(size_t)k * N + n] * gk : 0.f; }
    __syncthreads();
    { const int nn = tid >> 3, kc = tid & 7, n = n0 + nn;
      if (n < N) { int row = n; if (which == 2) row = n < 512 ? ((n >> 5) * 64 + (n & 31)) : (((n - 512) >> 5) * 64 + 32 + (n & 31));
        float v[8];
#pragma unroll
        for (int e = 0; e < 8; ++e) v[e] = T[(kc * 8 + e) * 65 + nn];
        u32x4 w = {cvtpk(v[0], v[1]), cvtpk(v[2], v[3]), cvtpk(v[4], v[5]), cvtpk(v[6], v[7])};
        *(u32x4*)(dst + (size_t)row * ldk + k0 + kc * 8) = w; } }
    __syncthreads();
  }
}
__device__ __forceinline__ void prep_all(const P& p, char* lds) {
  const size_t gid = blockIdx.x * (size_t)blockDim.x + threadIdx.x, gsz = gridDim.x * (size_t)blockDim.x;
  prep_transposes(p, lds);
  { float* bglu = WSP(float, O_BGLU);
    for (size_t i = gid; i < 1024; i += gsz) { const int sc = (int)i; const int n = sc < 512 ? ((sc >> 5) * 64 + (sc & 31)) : (((sc - 512) >> 5) * 64 + 32 + (sc & 31)); bglu[n] = p.b_glu[sc]; } }
  { const int lane = threadIdx.x & 63; bf16* xb = WSP(bf16, O_XB); float* rsx = WSP(float, O_RSX);
    for (size_t row = gid >> 6; row < (size_t)RT; row += gsz >> 6) { const float* xr = xrow(p, (int)row); float ss = 0.f;
#pragma unroll
      for (int q = 0; q < 4; ++q) { const f32x4v v = *(const f32x4v*)(xr + q * 256 + lane * 4); ss += v[0] * v[0] + v[1] * v[1] + v[2] * v[2] + v[3] * v[3];
        uint2 w; w.x = cvtpk(v[0], v[1]); w.y = cvtpk(v[2], v[3]); *(uint2*)(xb + row * LDK + q * 256 + lane * 4) = w; }
#pragma unroll
      for (int o = 32; o > 0; o >>= 1) ss += __shfl_xor(ss, o);
      if (lane == 0) rsx[row] = rsqrtf(ss * (1.f / DM) + EPS); } }
  float2* rope = WSP(float2, O_ROPE);
  for (size_t i = gid; i < (size_t)LTOT * 16; i += gsz) {
    int pos = i / 16, j = i % 16; float inv = powf(10000.f, -(float)j / 16.f); float ang = (float)pos * inv;
    float c, s; sincos_red((double)ang, c, s); rope[i] = make_float2(c, s); }
  float2* abar = WSP(float2, O_ABAR); float2* bbar = WSP(float2, O_BBAR);
  for (size_t i = gid; i < 2 * 32 * 64; i += gsz) {
    int dg = i / 64; double dt = exp((double)p.log_dt[dg]); double are = p.a_re[i], aim = p.a_im[i];
    double mag = exp(are * dt); float c, s; sincos_red(aim * dt, c, s);
    double br = mag * (double)c, bi = mag * (double)s;
    br = mag * cos(aim * dt); bi = mag * sin(aim * dt);
    abar[i] = make_float2((float)br, (float)bi);
    { float2* pw = WSP(float2, O_PW) + i * 17;
      double pr = 1.0, pi_ = 0.0;
      for (int d = 0; d <= 16; ++d) { pw[d] = make_float2((float)pr, (float)pi_); const double nr_ = pr * br - pi_ * bi, ni_ = pr * bi + pi_ * br; pr = nr_; pi_ = ni_; } }
    double nr = br - 1.0, ni = bi, den = are * are + aim * aim;
    double cr = (nr * are + ni * aim) / den, ci = (ni * are - nr * aim) / den;
    for (int h = 0; h < 16; ++h) { double b_r = p.b_re[i * 16 + h], b_i = p.b_im[i * 16 + h];
      bbar[i * 16 + h] = make_float2((float)(cr * b_r - ci * b_i), (float)(cr * b_i + ci * b_r)); }
  }
  bf16* kn = WSP(bf16, O_KN); bf16* vv = WSP(bf16, O_V); bf16* kr = WSP(bf16, O_KR);
  for (size_t i = gid; i < (size_t)NB * NH * KPAD * 64; i += gsz) { size_t bh = i / (KPAD * 64), rem = i % (KPAD * 64); kn[bh * NKEY * 64 + rem] = f2bf(0.f); vv[bh * NKEY * 64 + rem] = f2bf(0.f); }
  for (size_t i = gid; i < (size_t)NB * KPAD * 32; i += gsz) { size_t b = i / (KPAD * 32), rem = i % (KPAD * 32); kr[b * NKEY * 32 + rem] = f2bf(0.f); }
}

template <int RB> __device__ __forceinline__ int swz(int row, int chunk) { return row * RB + ((chunk ^ ((row / (256 / RB)) & (RB / 16 - 1))) << 4); }

constexpr int LDS_ROWSS = 131072;
constexpr int LDS_RED = LDS_ROWSS + 1024;
constexpr int LDS_BYTES = LDS_RED + 2048;

struct ALX {
  const float* x; const float* meta;
  struct Raw { f32x4v a, b; };
  __device__ __forceinline__ Raw load(int m, int k) const { m = m < RT ? m : RT - 1;
    const float* r = (m < RX ? x + (size_t)m * DM : meta + (size_t)(m - RX) * DM) + k; Raw v; v.a = *(const f32x4v*)r; v.b = *(const f32x4v*)(r + 4); return v; }
  __device__ __forceinline__ bf16x8 cvt(const Raw& v, int k, float& ss) const {
    ss += v.a[0] * v.a[0] + v.a[1] * v.a[1] + v.a[2] * v.a[2] + v.a[3] * v.a[3] + v.b[0] * v.b[0] + v.b[1] * v.b[1] + v.b[2] * v.b[2] + v.b[3] * v.b[3];
    u32x4 w = {cvtpk(v.a[0], v.a[1]), cvtpk(v.a[2], v.a[3]), cvtpk(v.b[0], v.b[1]), cvtpk(v.b[2], v.b[3])}; return (bf16x8)w; }
};
__device__ __forceinline__ float ss8(u32x4 v) { float s = 0.f;
#pragma unroll
  for (int j = 0; j < 4; ++j) { float a = bflo(v[j]), b = bfhi(v[j]); s += a * a + b * b; } return s; }
struct ALB {
  const bf16* a; int ld; int mmax; using Raw = u32x4;
  __device__ __forceinline__ Raw load(int m, int k) const { m = m < mmax ? m : mmax; return *(const u32x4*)(a + (size_t)m * ld + k); }
  __device__ __forceinline__ bf16x8 cvt(const Raw& v, int k, float& ss) const { ss += ss8(v); return (bf16x8)v; }
};
struct ALBn {
  const bf16* a; int ld; int mmax; using Raw = u32x4;
  __device__ __forceinline__ Raw load(int m, int k) const { m = m < mmax ? m : mmax; return *(const u32x4*)(a + (size_t)m * ld + k); }
  __device__ __forceinline__ bf16x8 cvt(const Raw& v, int k, float& ss) const { return (bf16x8)v; }
};
struct ALOut {
  const bf16* ya; const bf16* ysn; using Raw = u32x4;
  __device__ __forceinline__ Raw load(int m, int k) const { return *(const u32x4*)(k < 512 ? ya + (size_t)m * 512 + k : ysn + (size_t)m * 512 + (k - 512)); }
  __device__ __forceinline__ bf16x8 cvt(const Raw& v, int k, float& ss) const { if (k < 512) ss += ss8(v); return (bf16x8)v; }
};

template <int BM, int BN, int BK, int WGM, int WGN, int MIDKT, class AL>
__device__ __forceinline__ void gemm_main(char* lds, const AL& al, int m0, const bf16* __restrict__ Bt, int ldb, int n0, int nmax, int K,
                                          f32x16 (&acc)[BM / WGM / 32][BN / WGN / 32], const float* midsc = nullptr) {
  constexpr int CPR = BK / 8, RB = BK * 2, RPS = 512 / CPR, A_CH = (BM + RPS - 1) / RPS, B_CH = BN / RPS;
  constexpr int TM = BM / WGM / 32, TN = BN / WGN / 32, A_BYTES = BM * RB, STAGE = (BM + BN) * RB;
  const int tid = otid(), lane = tid & 63, wid = tid >> 6, wm = wid / WGN, wn = wid % WGN, r32 = lane & 31, hi = lane >> 5;
  const int srow = tid / CPR, sch = tid % CPR;
  float* rowss = (float*)(lds + LDS_ROWSS);
  typename AL::Raw ra[A_CH]; u32x4 rb[B_CH]; float ss[A_CH];
#pragma unroll
  for (int i = 0; i < A_CH; ++i) ss[i] = 0.f;
#pragma unroll
  for (int i = 0; i < TM; ++i)
#pragma unroll
    for (int j = 0; j < TN; ++j)
#pragma unroll
      for (int r = 0; r < 16; ++r) acc[i][j][r] = 0.f;
#define GLOAD(kt) do { const int k_ = (kt) * BK + sch * 8; \
    _Pragma("unroll") for (int i = 0; i < A_CH; ++i) if (BM % RPS == 0 || srow + i * RPS < BM) ra[i] = al.load(m0 + srow + i * RPS, k_); \
    _Pragma("unroll") for (int i = 0; i < B_CH; ++i) { int n_ = n0 + srow + i * RPS; n_ = n_ < nmax ? n_ : nmax; rb[i] = *(const u32x4*)(Bt + (size_t)n_ * ldb + k_); } } while (0)
#define SWRITE(buf, kt) do { char* base_ = lds + (buf) * STAGE; const int k_ = (kt) * BK + sch * 8; \
    _Pragma("unroll") for (int i = 0; i < A_CH; ++i) if (BM % RPS == 0 || srow + i * RPS < BM) *(bf16x8*)(base_ + swz<RB>(srow + i * RPS, sch)) = al.cvt(ra[i], k_, ss[i]); \
    _Pragma("unroll") for (int i = 0; i < B_CH; ++i) *(u32x4*)(base_ + A_BYTES + swz<RB>(srow + i * RPS, sch)) = rb[i]; } while (0)
#define PUBSS() do { \
    _Pragma("unroll") for (int i = 0; i < A_CH; ++i) { float s_ = ss[i]; \
      _Pragma("unroll") for (int o = 1; o < CPR; o <<= 1) s_ += __shfl_xor(s_, o); \
      if (sch == 0 && (BM % RPS == 0 || srow + i * RPS < BM)) rowss[srow + i * RPS] = s_; } \
    __syncthreads(); } while (0)
  const int nk = K / BK;
  GLOAD(0); SWRITE(0, 0); __syncthreads();
#pragma unroll 1
  for (int kt = 0; kt < nk; ++kt) {
    if (kt + 1 < nk) GLOAD(kt + 1);
    if (MIDKT >= 0 && kt == MIDKT) {
      PUBSS();
#pragma unroll
      for (int i = 0; i < TM; ++i)
      { float rs = rsqrtf(rowss[wm * (TM * 32) + i * 32 + r32] * (1.f / 512.f) + EPS); if (midsc) rs *= midsc[wm * (TM * 32) + i * 32 + r32];
#pragma unroll
        for (int j = 0; j < TN; ++j)
#pragma unroll
          for (int r = 0; r < 16; ++r) acc[i][j][r] *= rs; }
    }
    const char* base = lds + (kt & 1) * STAGE;
#pragma unroll
    for (int ks = 0; ks < BK / 16; ++ks) {
      bf16x8 af[TM], bfr[TN];
#pragma unroll
      for (int i = 0; i < TM; ++i) af[i] = *(const bf16x8*)(base + swz<RB>(wm * (TM * 32) + i * 32 + r32, ks * 2 + hi));
#pragma unroll
      for (int j = 0; j < TN; ++j) bfr[j] = *(const bf16x8*)(base + A_BYTES + swz<RB>(wn * (TN * 32) + j * 32 + r32, ks * 2 + hi));
#pragma unroll
      for (int i = 0; i < TM; ++i)
#pragma unroll
        for (int j = 0; j < TN; ++j) acc[i][j] = __builtin_amdgcn_mfma_f32_32x32x16_bf16(bfr[j], af[i], acc[i][j], 0, 0, 0);
    }
    if (kt + 1 < nk) SWRITE((kt + 1) & 1, kt + 1);
    __syncthreads();
  }
  if (MIDKT < 0) PUBSS();
#undef GLOAD
#undef SWRITE
#undef PUBSS
}

__device__ __forceinline__ int row_pos(int m) { return m < RX ? (m & (SEQ - 1)) + NMETA : m - RX; }
__device__ __forceinline__ uint2 pack4(float a, float b, float c, float d) { uint2 w; w.x = cvtpk(a, b); w.y = cvtpk(c, d); return w; }
__device__ __forceinline__ void rope_block(f32x16& v, const float2* rope_pos, int hi) {
#pragma unroll
  for (int g = 0; g < 2; ++g)
#pragma unroll
    for (int e = 0; e < 4; ++e) { const int r = 4 * g + e; const float2 cs = rope_pos[8 * g + 4 * hi + e];
      const float x1 = v[r], x2 = v[r + 8]; v[r] = x1 * cs.x - x2 * cs.y; v[r + 8] = x1 * cs.y + x2 * cs.x; }
}

constexpr int NT_INPROJ = 5 * 256;
__device__ __forceinline__ void inproj_xform(const P& p, f32x16& a, int m, int nb, int hi, float rs) {
#pragma unroll
  for (int r = 0; r < 16; ++r) a[r] *= rs;
  if (nb == 384) rope_block(a, WSP(float2, O_ROPE) + row_pos(m < RT ? m : RT - 1) * 16, hi);
  else if ((nb >= 416 && nb < 928) || nb >= 1440) {
#pragma unroll
    for (int r = 0; r < 16; ++r) a[r] = silu(a[r]); }
}
constexpr int EP_RS = 144;
__device__ __forceinline__ void inproj_rows(const P& p, char* wl, f32x16& a0, f32x16& a1, int mrow0, int nb0, int lane, int r32, int hi) {
  const int m = mrow0 + r32; const float rs = WSP(float, O_RSX)[m < RT ? m : RT - 1];
  inproj_xform(p, a0, m, nb0, hi, rs); inproj_xform(p, a1, m, nb0 + 32, hi, rs);
#pragma unroll
  for (int g = 0; g < 4; ++g) {
    *(uint2*)(wl + r32 * EP_RS + (8 * g + 4 * hi) * 2) = pack4(a0[4 * g], a0[4 * g + 1], a0[4 * g + 2], a0[4 * g + 3]);
    *(uint2*)(wl + r32 * EP_RS + (32 + 8 * g + 4 * hi) * 2) = pack4(a1[4 * g], a1[4 * g + 1], a1[4 * g + 2], a1[4 * g + 3]); }
#pragma unroll
  for (int it = 0; it < 4; ++it) {
    const int row = it * 8 + (lane >> 3), ch = lane & 7, mm = mrow0 + row, n = nb0 + ch * 8;
    const u32x4 v = *(const u32x4*)(wl + row * EP_RS + ch * 16);
    if (n >= DIN || mm >= RT) continue;
    bf16* dst;
    if (n < 256) dst = WSP(bf16, O_QLAT) + (size_t)mm * QL + n;
    else if (n < 384) dst = WSP(bf16, O_KVLAT) + (size_t)mm * KVL + (n - 256);
    else if (n < 416) { const int pos = row_pos(mm), c = n - 384; bf16* kr = WSP(bf16, O_KR);
      if (mm < RX) dst = kr + ((size_t)(mm >> 14) * NKEY + KPAD + pos) * 32 + c;
      else { *(u32x4*)(kr + ((size_t)NKEY + KPAD + pos) * 32 + c) = v; dst = kr + ((size_t)KPAD + pos) * 32 + c; } }
    else if (n < 928) { if (mm >= RX) continue; dst = WSP(bf16, O_AGATE) + (size_t)mm * DA + (n - 416); }
    else if (n < 1440) { const int c = n - 928; dst = WSP(bf16, O_SUG) + ((size_t)(c >> 4) * RP + mm) * GH + (c & 15); }
    else { if (mm >= RX) continue; dst = WSP(bf16, O_SGATE) + (size_t)mm * DS + (n - 1440); }
    *(u32x4*)dst = v;
  }
}
__device__ __forceinline__ void phase_inproj(const P& p, int tile, char* lds) {
  const int rnd = tile >> 8, s = tile & 255, xcd = s & 7, slot = s >> 3;
  const int mt = rnd * 32 + xcd * 4 + (slot >> 3), nt = slot & 7;
  if (mt > 128) return;
  const int m0 = mt * 256, n0 = nt * 256;
  f32x16 acc[4][2]; ALBn al{WSP(bf16, O_XB), LDK, RT - 1};
  gemm_main<256, 256, 64, 2, 4, -1>(lds, al, m0, WSP(bf16, O_WTIN), LDK, n0, DIN - 1, DM, acc);
  const int tid_ = otid(), lane = tid_ & 63, wid = tid_ >> 6, wm = wid >> 2, wn = wid & 3, r32 = lane & 31, hi = lane >> 5;
  const int mw = m0 + wm * 128, nb = n0 + wn * 64; char* wl = lds + wid * (32 * EP_RS);
  inproj_rows(p, wl, acc[0][0], acc[0][1], mw, nb, lane, r32, hi);
  inproj_rows(p, wl, acc[1][0], acc[1][1], mw + 32, nb, lane, r32, hi);
  inproj_rows(p, wl, acc[2][0], acc[2][1], mw + 64, nb, lane, r32, hi);
  inproj_rows(p, wl, acc[3][0], acc[3][1], mw + 96, nb, lane, r32, hi);
  __syncthreads();
}
constexpr int NT_QUP = (RX / 256) * 3, NT_KVUP = (RP / 256) * 4;
__device__ __forceinline__ void qup_epi(const P& p, f32x16 a, int m, int nb, int hi, float rs) {
  const int h = nb / DQK, c0 = nb % DQK, b = m >> 14, ii = m & (SEQ - 1);
#pragma unroll
  for (int r = 0; r < 16; ++r) a[r] *= rs;
  if (c0 == 64) rope_block(a, WSP(float2, O_ROPE) + (ii + NMETA) * 16, hi);
  bf16* dst = WSP(bf16, O_Q) + (((size_t)b * NH + h) * SEQ + ii) * DQK + c0 + 4 * hi;
#pragma unroll
  for (int g = 0; g < 4; ++g) *(uint2*)(dst + 8 * g) = pack4(a[4 * g], a[4 * g + 1], a[4 * g + 2], a[4 * g + 3]);
}
__device__ __forceinline__ void phase_qup(const P& p, int tile, char* lds) {
  const int mt = tile / 3, nt = tile % 3, m0 = mt * 256, n0 = nt * 256;
  f32x16 acc[4][2]; ALB al{WSP(bf16, O_QLAT), QL, RT - 1};
  gemm_main<256, 256, 64, 2, 4, -1>(lds, al, m0, WSP(bf16, O_WTQ), QL, n0, 767, QL, acc);
  const int tid_ = otid(), lane = tid_ & 63, wid = tid_ >> 6, wm = wid >> 2, wn = wid & 3, r32 = lane & 31, hi = lane >> 5;
  const float* rowss = (const float*)(lds + LDS_ROWSS); const int lr = wm * 128 + r32, nb = n0 + wn * 64;
  constexpr float QC = 0.10206207261596577f * 1.4426950408889634f;
#define QROW(i) do { const float rs_ = rsqrtf(rowss[lr + 32 * (i)] * (1.f / QL) + EPS) * QC; qup_epi(p, acc[i][0], m0 + lr + 32 * (i), nb, hi, rs_); qup_epi(p, acc[i][1], m0 + lr + 32 * (i), nb + 32, hi, rs_); } while (0)
  QROW(0); QROW(1); QROW(2); QROW(3);
#undef QROW
  __syncthreads();
}
__device__ __forceinline__ void kvup_epi(const P& p, const f32x16& a, int m, int nb, int hi, float rs) {
  if (m >= RT) return;
  const int h = nb >> 7, c0 = nb & 127; bf16* base = c0 < 64 ? WSP(bf16, O_KN) : WSP(bf16, O_V); const int c = (c0 & 63) + 4 * hi;
#pragma unroll
  for (int g = 0; g < 4; ++g) { const uint2 w = pack4(a[4 * g] * rs, a[4 * g + 1] * rs, a[4 * g + 2] * rs, a[4 * g + 3] * rs);
    if (m < RX) *(uint2*)(base + (((size_t)(m >> 14) * NH + h) * NKEY + KPAD + NMETA + (m & (SEQ - 1))) * 64 + c + 8 * g) = w;
    else { const int jk = KPAD + (m - RX); *(uint2*)(base + ((size_t)h * NKEY + jk) * 64 + c + 8 * g) = w; *(uint2*)(base + (((size_t)NH + h) * NKEY + jk) * 64 + c + 8 * g) = w; } }
}
__device__ __forceinline__ void phase_kvup(const P& p, int tile, char* lds) {
  const int mt = tile >> 2, nt = tile & 3, m0 = mt * 256, n0 = nt * 256;
  f32x16 acc[4][2]; ALB al{WSP(bf16, O_KVLAT), KVL, RT - 1};
  gemm_main<256, 256, 64, 2, 4, -1>(lds, al, m0, WSP(bf16, O_WTKV), KVL, n0, 1023, KVL, acc);
  const int tid_ = otid(), lane = tid_ & 63, wid = tid_ >> 6, wm = wid >> 2, wn = wid & 3, r32 = lane & 31, hi = lane >> 5;
  const float* rowss = (const float*)(lds + LDS_ROWSS); const int lr = wm * 128 + r32, nb = n0 + wn * 64;
#define KVROW(i) do { const float rs_ = rsqrtf(rowss[lr + 32 * (i)] * (1.f / KVL) + EPS); kvup_epi(p, acc[i][0], m0 + lr + 32 * (i), nb, hi, rs_); kvup_epi(p, acc[i][1], m0 + lr + 32 * (i), nb + 32, hi, rs_); } while (0)
  KVROW(0); KVROW(1); KVROW(2); KVROW(3);
#undef KVROW
  __syncthreads();
}
__device__ __forceinline__ float pair_sum(float v) { return v + __shfl_xor(v, 32); }
constexpr int NT_GLU = 512;
__device__ __forceinline__ void glu_epi(const P& p, const f32x16& av, const f32x16& ag, int m, int q, int hi) {
  const float* bg = WSP(float, O_BGLU); const bf16* sg = WSP(bf16, O_SGATE); bf16* yrow = WSP(bf16, O_YSN) + (size_t)m * DS + q * 32; float part = 0.f;
#pragma unroll
  for (int g = 0; g < 4; ++g) { const int cc = 8 * g + 4 * hi; const f32x4v ba = *(const f32x4v*)(bg + q * 64 + cc), bgt = *(const f32x4v*)(bg + q * 64 + 32 + cc);
    const uint2 gw = *(const uint2*)(sg + (size_t)m * DS + q * 32 + cc); const float gt[4] = {bflo(gw.x), bfhi(gw.x), bflo(gw.y), bfhi(gw.y)}; float v[4];
#pragma unroll
    for (int e = 0; e < 4; ++e) { const float a_ = av[4 * g + e] + ba[e], g_ = ag[4 * g + e] + bgt[e]; v[e] = a_ / (1.f + __expf(-g_)) * gt[e]; part += v[e] * v[e]; }
    *(uint2*)(yrow + cc) = pack4(v[0], v[1], v[2], v[3]); }
  part = pair_sum(part);
  if (hi == 0) WSP(float, O_GPART)[(size_t)q * RX + m] = part;
}
__device__ __forceinline__ void phase_glu(const P& p, int tile, char* lds) {
  const int rnd = tile >> 8, s = tile & 255, xcd = s & 7, slot = s >> 3, mt = rnd * 64 + xcd * 8 + (slot >> 2), nt = slot & 3, m0 = mt * 256;
  f32x16 acc[4][2]; ALBn al{WSP(bf16, O_YSG), DS, RX - 1};
  gemm_main<256, 256, 64, 2, 4, -1>(lds, al, m0, WSP(bf16, O_WTGLU), DS, nt * 256, 1023, DS, acc);
  const int tid_ = otid(), lane = tid_ & 63, wid = tid_ >> 6, wm = wid >> 2, wn = wid & 3, r32 = lane & 31, hi = lane >> 5;
  const int m = m0 + wm * 128 + r32, q = nt * 4 + wn;
  glu_epi(p, acc[0][0], acc[0][1], m, q, hi); glu_epi(p, acc[1][0], acc[1][1], m + 32, q, hi);
  glu_epi(p, acc[2][0], acc[2][1], m + 64, q, hi); glu_epi(p, acc[3][0], acc[3][1], m + 96, q, hi);
  __syncthreads();
}
constexpr int NT_OUT = 512;
__device__ __forceinline__ float out_epi(const P& p, const f32x16& a, int m, int nb, int hi, float sc) {
  bf16* yrow = WSP(bf16, O_Y) + (size_t)m * DM + nb + 4 * hi; float part = 0.f;
#pragma unroll
  for (int g = 0; g < 4; ++g) { const float v0 = a[4 * g] * sc, v1 = a[4 * g + 1] * sc, v2 = a[4 * g + 2] * sc, v3 = a[4 * g + 3] * sc;
    part += v0 * v0 + v1 * v1 + v2 * v2 + v3 * v3; *(uint2*)(yrow + 8 * g) = pack4(v0, v1, v2, v3); }
  return part;
}
__device__ __forceinline__ void phase_out(const P& p, int tile, char* lds) {
  const int rnd = tile >> 8, s = tile & 255, xcd = s & 7, slot = s >> 3, mt = rnd * 64 + xcd * 8 + (slot >> 2), nt = slot & 3, m0 = mt * 256;
  float* isc = (float*)(lds + LDS_RED);
  { const int t = otid(); if (t < 256) { const float* gp = WSP(float, O_GPART) + m0 + t; float sq = 0.f;
#pragma unroll
      for (int q = 0; q < 16; ++q) sq += gp[(size_t)q * RX];
      isc[t] = sqrtf(sq * (1.f / DS) + EPS); } }
  __syncthreads();
  f32x16 acc[4][2]; ALOut al{WSP(bf16, O_YA), WSP(bf16, O_YSN)};
  gemm_main<256, 256, 64, 2, 4, 8>(lds, al, m0, WSP(bf16, O_WTOUT), DM, nt * 256, 1023, DM, acc, isc);
  const int tid_ = otid(), lane = tid_ & 63, wid = tid_ >> 6, wm = wid >> 2, wn = wid & 3, r32 = lane & 31, hi = lane >> 5;
  const int lr = wm * 128 + r32, m = m0 + lr, nb = nt * 256 + wn * 64; float* yp = WSP(float, O_YPART) + (size_t)(nt * 4 + wn) * RX;
#define OUT_ROW(i) do { const float sc_ = 1.f / isc[lr + 32 * (i)]; float part_ = out_epi(p, acc[i][0], m + 32 * (i), nb, hi, sc_) + out_epi(p, acc[i][1], m + 32 * (i), nb + 32, hi, sc_); \
    part_ = pair_sum(part_); if (hi == 0) yp[m + 32 * (i)] = part_; } while (0)
  OUT_ROW(0); OUT_ROW(1); OUT_ROW(2); OUT_ROW(3);
#undef OUT_ROW
  __syncthreads();
}
__device__ __forceinline__ void phase_final(const P& p) {
  const int t = threadIdx.x, rsub = t >> 7, c = (t & 127) * 8; const float* yp = WSP(float, O_YPART);
  const f32x4v w0 = *(const f32x4v*)(p.post_w + c), w1 = *(const f32x4v*)(p.post_w + c + 4);
  for (int row = blockIdx.x * 4 + rsub; row < RX; row += gridDim.x * 4) {
    float sq = 0.f;
#pragma unroll
    for (int q = 0; q < 16; ++q) sq += yp[(size_t)q * RX + row];
    const float rs = rsqrtf(sq * (1.f / DM) + EPS);
    const u32x4 yv = *(const u32x4*)(WSP(bf16, O_Y) + (size_t)row * DM + c);
    const f32x4v x0 = *(const f32x4v*)(p.x + (size_t)row * DM + c), x1 = *(const f32x4v*)(p.x + (size_t)row * DM + c + 4);
    f32x4v o0, o1;
    o0[0] = x0[0] + bflo(yv[0]) * rs * w0[0]; o0[1] = x0[1] + bfhi(yv[0]) * rs * w0[1]; o0[2] = x0[2] + bflo(yv[1]) * rs * w0[2]; o0[3] = x0[3] + bfhi(yv[1]) * rs * w0[3];
    o1[0] = x1[0] + bflo(yv[2]) * rs * w1[0]; o1[1] = x1[1] + bfhi(yv[2]) * rs * w1[1]; o1[2] = x1[2] + bflo(yv[3]) * rs * w1[2]; o1[3] = x1[3] + bfhi(yv[3]) * rs * w1[3];
    *(f32x4v*)(p.out + (size_t)row * DM + c) = o0; *(f32x4v*)(p.out + (size_t)row * DM + c + 4) = o1;
  }
}

using s16x4 = __attribute__((ext_vector_type(4))) short;
constexpr float ATT_SCALE = 0.10206207261596577f;
constexpr float ATT_THR = 8.f;
constexpr int A_SHM_V = 8192, A_SHM_KN = 8192, A_SHM_KR = 4096;
constexpr int A_OFF_V = 0, A_OFF_KN = 2 * A_SHM_V, A_OFF_KR = A_OFF_KN + 2 * A_SHM_KN, A_OFF_WS = A_OFF_KR + 2 * A_SHM_KR;
#define SBAR() __builtin_amdgcn_sched_barrier(0)
__device__ __forceinline__ unsigned cvtpkv(float lo, float hi) { unsigned r; asm volatile("v_cvt_pk_bf16_f32 %0, %1, %2" : "=v"(r) : "v"(lo), "v"(hi)); return r; }
constexpr float ATT_THR2 = 60.f;
__device__ __forceinline__ float rowmaxSM(const f32x16& p0, const f32x16& p1) {
  float pmax = p0[0];
#pragma unroll
  for (int r = 1; r < 16; ++r) pmax = fmaxf(pmax, p0[r]);
#pragma unroll
  for (int r = 0; r < 16; ++r) pmax = fmaxf(pmax, p1[r]);
  auto rr = __builtin_amdgcn_permlane32_swap(__float_as_uint(pmax), __float_as_uint(pmax), false, false);
  return fmaxf(__uint_as_float(rr[0]), __uint_as_float(rr[1]));
}
__device__ __forceinline__ void decideSM(f32x16& p0, f32x16& p1, float pmax, float& m_reg, float& alpha, bool& zref) {
  if (__builtin_expect(__all(pmax <= ATT_THR2), 1)) { alpha = 1.f; }
  else { const float delta = fmaxf(pmax, 0.f); alpha = __builtin_amdgcn_exp2f(-delta); m_reg += delta; zref = false;
#pragma unroll
    for (int r = 0; r < 16; ++r) { p0[r] -= delta; p1[r] -= delta; } }
#pragma unroll
  for (int r = 0; r < 16; ++r) p0[r] = __builtin_amdgcn_exp2f(p0[r]);
}
__device__ __forceinline__ void firstSM(f32x16& p0, f32x16& p1, float pmax, float& m_reg, float& alpha, bool& zref) {
  alpha = 1.f;
  if (!__all(fabsf(pmax) <= ATT_THR2)) { const float delta = fabsf(pmax) <= ATT_THR2 ? 0.f : pmax; m_reg = delta; zref = false;
#pragma unroll
    for (int r = 0; r < 16; ++r) { p0[r] -= delta; p1[r] -= delta; } }
#pragma unroll
  for (int r = 0; r < 16; ++r) p0[r] = __builtin_amdgcn_exp2f(p0[r]);
}
#define SCHEDPAT() do { _Pragma("unroll") for (int i_ = 0; i_ < 20; ++i_) { __builtin_amdgcn_sched_group_barrier(0x008, 1, 0); __builtin_amdgcn_sched_group_barrier(0x002, 4, 0); } } while (0)
__device__ __forceinline__ void finishSM(f32x16& p0, f32x16& p1, float alpha, float& l_reg, bf16x8& pa0, bf16x8& pa1, bf16x8& pa2, bf16x8& pa3) {
#pragma unroll
  for (int r = 0; r < 16; ++r) p1[r] = __builtin_amdgcn_exp2f(p1[r]);
  float ps = 0;
#pragma unroll
  for (int r = 0; r < 16; ++r) ps += p0[r];
#pragma unroll
  for (int r = 0; r < 16; ++r) ps += p1[r];
  { auto rr = __builtin_amdgcn_permlane32_swap(__float_as_uint(ps), __float_as_uint(ps), false, false);
    ps = __uint_as_float(rr[0]) + __uint_as_float(rr[1]); }
  l_reg = l_reg * alpha + ps;
#define PK4(Pv, BASE, OUT) do { u32x4 w = {cvtpkv(Pv[BASE + 0], Pv[BASE + 1]), cvtpkv(Pv[BASE + 2], Pv[BASE + 3]), cvtpkv(Pv[BASE + 4], Pv[BASE + 5]), cvtpkv(Pv[BASE + 6], Pv[BASE + 7])}; \
    OUT = (bf16x8)w; } while (0)
  PK4(p0, 0, pa0); PK4(p0, 8, pa1); PK4(p1, 0, pa2); PK4(p1, 8, pa3);
#undef PK4
}
__device__ __forceinline__ void qkt(f32x16& p0, f32x16& p1, const char* Kn, const char* Kr, const bf16x8* qr, int r32, int hi, float init) {
#pragma unroll
  for (int r = 0; r < 16; ++r) { p0[r] = init; p1[r] = init; }
#pragma unroll
  for (int d0 = 0; d0 < 4; ++d0) {
    bf16x8 b0 = *(const bf16x8*)(Kn + swz<128>(r32, d0 * 2 + hi));
    bf16x8 b1 = *(const bf16x8*)(Kn + swz<128>(32 + r32, d0 * 2 + hi));
    p0 = __builtin_amdgcn_mfma_f32_32x32x16_bf16(b0, qr[d0], p0, 0, 0, 0);
    p1 = __builtin_amdgcn_mfma_f32_32x32x16_bf16(b1, qr[d0], p1, 0, 0, 0); }
#pragma unroll
  for (int d0 = 0; d0 < 2; ++d0) {
    bf16x8 b0 = *(const bf16x8*)(Kr + swz<64>(r32, d0 * 2 + hi));
    bf16x8 b1 = *(const bf16x8*)(Kr + swz<64>(32 + r32, d0 * 2 + hi));
    p0 = __builtin_amdgcn_mfma_f32_32x32x16_bf16(b0, qr[4 + d0], p0, 0, 0, 0);
    p1 = __builtin_amdgcn_mfma_f32_32x32x16_bf16(b1, qr[4 + d0], p1, 0, 0, 0); }
}
__device__ __forceinline__ int v_st(int k, int c) { const int kk = k;     return ((kk >> 3) * 2 + (c >> 5)) * 512 + ((kk & 7) * 32 + (c & 31)) * 2; }
__device__ __forceinline__ int v_rd_base(int lane) { return ((lane & 3) << 3) | (((lane >> 2) & 3) << 6) | (((lane >> 4) & 1) << 5) | (((lane >> 5) & 1) << 8); }
constexpr int v_rd_off(int d0, int ks, int half) { return d0 * 512 + ks * 2048 + half * 1024; }
template <int OFF> __device__ __forceinline__ s16x4 tr_read(int vb) {
  return __builtin_amdgcn_ds_read_tr16_b64_v4i16((__attribute__((address_space(3))) s16x4*)(uintptr_t)(unsigned)(vb + OFF));
}
template <int D0> __device__ __forceinline__ void pv_one(f32x16& od, int vb, bf16x8 pa0, bf16x8 pa1, bf16x8 pa2, bf16x8 pa3) {
  const s16x4 l0 = tr_read<v_rd_off(D0, 0, 0)>(vb), h0 = tr_read<v_rd_off(D0, 0, 1)>(vb), l1 = tr_read<v_rd_off(D0, 1, 0)>(vb), h1 = tr_read<v_rd_off(D0, 1, 1)>(vb);
  const s16x4 l2 = tr_read<v_rd_off(D0, 2, 0)>(vb), h2 = tr_read<v_rd_off(D0, 2, 1)>(vb), l3 = tr_read<v_rd_off(D0, 3, 0)>(vb), h3 = tr_read<v_rd_off(D0, 3, 1)>(vb);
#define PKV(L, H) (bf16x8){L[0], L[1], L[2], L[3], H[0], H[1], H[2], H[3]}
  od = __builtin_amdgcn_mfma_f32_32x32x16_bf16(PKV(l0, h0), pa0, od, 0, 0, 0);
  od = __builtin_amdgcn_mfma_f32_32x32x16_bf16(PKV(l1, h1), pa1, od, 0, 0, 0);
  od = __builtin_amdgcn_mfma_f32_32x32x16_bf16(PKV(l2, h2), pa2, od, 0, 0, 0);
  od = __builtin_amdgcn_mfma_f32_32x32x16_bf16(PKV(l3, h3), pa3, od, 0, 0, 0);
#undef PKV
}
constexpr int NT_ATTN = NB * NH * (SEQ / 256);
constexpr int ATT_NT = NKEY / 64;
#ifndef ATT_FORCE_FALLBACK
#define ATT_FORCE_FALLBACK 0
#endif
template <bool FAST> __device__ __forceinline__ void attn_item(const P& p, int item, char* lds) {
  const int rnd = item >> 8, s = item & 255, xcd = s & 7, idx = s >> 3;
  const int bh = rnd * 4 + (xcd >> 1), qblk = (xcd & 1) * 32 + idx, b = bh >> 3, h = bh & 7, i0 = qblk * 256;
  const int tid = otid(), wid = tid >> 6, lane = tid & 63, r32 = lane & 31, hi = lane >> 5;
  const bf16* Qb = WSP(bf16, O_Q) + ((size_t)bh * SEQ + i0) * DQK;
  const bf16* Knh = WSP(bf16, O_KN) + (size_t)bh * NKEY * 64; const bf16* Vh = WSP(bf16, O_V) + (size_t)bh * NKEY * 64;
  const bf16* Krb = WSP(bf16, O_KR) + (size_t)b * NKEY * 32;
  char* V_lds = lds + A_OFF_V; char* Kn_lds = lds + A_OFF_KN; char* Kr_lds = lds + A_OFF_KR;
  volatile unsigned* redo = (volatile unsigned*)(lds + A_OFF_WS);
  if (FAST && tid == 0) *redo = 0u;
  float m_reg = 0.f, l_reg = 0; bool zref = true; f32x16 o[2]; bf16x8 qr[6];
#pragma unroll
  for (int r = 0; r < 16; ++r) { o[0][r] = 0.f; o[1][r] = 0.f; }
  const bf16* Qw = Qb + (size_t)(wid * 32 + r32) * DQK + hi * 8;
#pragma unroll
  for (int d0 = 0; d0 < 6; ++d0) qr[d0] = *(const bf16x8*)(Qw + d0 * 16);
  const int sr = tid >> 3, sc = tid & 7;
  const int vst = v_st(sr, sc * 8), knst = swz<128>(sr, sc), krst = swz<64>(sr, sc >> 1) + (sc & 1) * 8;
  const int vb0 = (int)(uintptr_t)V_lds + v_rd_base(lane);
  struct { u32x4 v, kn; uint2 kr; } st_[2];
#define SLOAD(i, k0) do { st_[i].v = *(const u32x4*)(Vh + (size_t)((k0) + sr) * 64 + sc * 8); st_[i].kn = *(const u32x4*)(Knh + (size_t)((k0) + sr) * 64 + sc * 8); \
    st_[i].kr = *(const uint2*)(Krb + (size_t)((k0) + sr) * 32 + sc * 4); } while (0)
#define SWRITE(bq, i) do { *(u32x4*)(V_lds + (bq) * A_SHM_V + vst) = st_[i].v; *(u32x4*)(Kn_lds + (bq) * A_SHM_KN + knst) = st_[i].kn; \
    *(uint2*)(Kr_lds + (bq) * A_SHM_KR + krst) = st_[i].kr; } while (0)
#define SWAIT() asm volatile("s_waitcnt vmcnt(3)" ::: "memory")
#define RESC(a) do { if (__any((a) < 1.f)) { _Pragma("unroll") for (int d = 0; d < 2; ++d) _Pragma("unroll") for (int r = 0; r < 16; ++r) o[d][r] *= (a); } } while (0)
#define PV(vbx) do { pv_one<0>(o[0], (vbx), pa0, pa1, pa2, pa3); pv_one<1>(o[1], (vbx), pa0, pa1, pa2, pa3); } while (0)
  f32x16 pA0, pA1, pB0, pB1; float alA, alB; bf16x8 pa0, pa1, pa2, pa3; constexpr int NT = ATT_NT;
  constexpr int SE = 0, SO = 1;
  if (wid >= 4) __builtin_amdgcn_s_setprio(1);
  SLOAD(SE, 0); asm volatile("s_waitcnt vmcnt(0)" ::: "memory"); SWRITE(0, SE); __syncthreads();
  qkt(pA0, pA1, Kn_lds, Kr_lds, qr, r32, hi, 0.f);
#pragma unroll
  for (int r = 0; r < 16; ++r) pA0[r] = -1e30f;
#pragma unroll
  for (int r = 0; r < 8; ++r) pA1[r] = -1e30f;
  { const float pm_ = rowmaxSM(pA0, pA1); firstSM(pA0, pA1, pm_, m_reg, alA, zref); }
  bool bad = FAST && !zref;
  SLOAD(SO, 64); SLOAD(SE, 128);
  SWAIT(); SWRITE(1, SO); __syncthreads();
  for (int j = 1; j + 1 < NT; j += 2) {
    if (FAST || zref) qkt(pB0, pB1, Kn_lds + A_SHM_KN, Kr_lds + A_SHM_KR, qr, r32, hi, 0.f); else qkt(pB0, pB1, Kn_lds + A_SHM_KN, Kr_lds + A_SHM_KR, qr, r32, hi, -m_reg);
    finishSM(pA0, pA1, alA, l_reg, pa0, pa1, pa2, pa3);
    SLOAD(SO, (j + 2 < NT ? j + 2 : NT - 1) * 64);
    PV(vb0);
    if (FAST) { SCHEDPAT(); alB = 1.f; _Pragma("unroll") for (int r = 0; r < 16; ++r) pB0[r] = __builtin_amdgcn_exp2f(pB0[r]); }
    else { const float pm_ = rowmaxSM(pB0, pB1); SCHEDPAT(); decideSM(pB0, pB1, pm_, m_reg, alB, zref); }
    __syncthreads(); SWAIT(); SWRITE(0, SE);
    if (!FAST) RESC(alB);
    __syncthreads();
    if (FAST || zref) qkt(pA0, pA1, Kn_lds, Kr_lds, qr, r32, hi, 0.f); else qkt(pA0, pA1, Kn_lds, Kr_lds, qr, r32, hi, -m_reg);
    finishSM(pB0, pB1, alB, l_reg, pa0, pa1, pa2, pa3);
    SLOAD(SE, (j + 3 < NT ? j + 3 : NT - 1) * 64);
    PV(vb0 + A_SHM_V);
    if (FAST) { SCHEDPAT(); alA = 1.f; _Pragma("unroll") for (int r = 0; r < 16; ++r) pA0[r] = __builtin_amdgcn_exp2f(pA0[r]); }
    else { const float pm_ = rowmaxSM(pA0, pA1); SCHEDPAT(); decideSM(pA0, pA1, pm_, m_reg, alA, zref); }
    __syncthreads(); SWAIT(); SWRITE(1, SO);
    if (!FAST) RESC(alA);
    __syncthreads();
  }
  __builtin_amdgcn_s_setprio(0);
  finishSM(pA0, pA1, alA, l_reg, pa0, pa1, pa2, pa3); SBAR();
  PV(vb0);
  if (FAST) { float chk = l_reg;
#pragma unroll
    for (int r = 0; r < 16; ++r) chk += fabsf(o[0][r]) + fabsf(o[1][r]);
    bad = bad || !(chk < 3.0e38f) || !(l_reg > 0.f) ; if (ATT_FORCE_FALLBACK) { int one_ = 1; asm volatile("" : "+v"(one_)); bad = bad || (one_ != 0); }
    if (__any(bad) && lane == 0) *redo = 1u; }
  { const float rl = __builtin_amdgcn_rcpf(l_reg); const size_t rowoff = (size_t)(b * SEQ + i0 + wid * 32 + r32) * DA + h * 64 + 4 * hi;
    const bf16* gate = WSP(bf16, O_AGATE) + rowoff; bf16* ya = WSP(bf16, O_YA) + rowoff;
#pragma unroll
    for (int d0 = 0; d0 < 2; ++d0)
#pragma unroll
      for (int g = 0; g < 4; ++g) { const uint2 gw = *(const uint2*)(gate + d0 * 32 + 8 * g);
        *(uint2*)(ya + d0 * 32 + 8 * g) = pack4(o[d0][4 * g] * rl * bflo(gw.x), o[d0][4 * g + 1] * rl * bfhi(gw.x), o[d0][4 * g + 2] * rl * bflo(gw.y), o[d0][4 * g + 3] * rl * bfhi(gw.y)); } }
  __syncthreads();
  bool again = false; if (FAST) { again = (*redo != 0u); __syncthreads(); }
#undef SLOAD
#undef SWRITE
#undef SWAIT
#undef RESC
#undef PV
  if (FAST) { if (again) attn_item<false>(p, item, lds); }
}


__device__ __forceinline__ void build_tables_p1(const P& p) {
  const size_t gid = blockIdx.x * 512ull + threadIdx.x, gsz = gridDim.x * 512ull;
  const float2* pw = WSP(float2, O_PW); const float2* bbar = WSP(float2, O_BBAR); float* Kt = WSP(float, O_KT); bf16* WS = WSP(bf16, O_WS);
  for (size_t i = gid; i < (size_t)2 * 32 * 16 * 256; i += gsz) { const int h = i & 15, hp = (i >> 4) & 15, d = (i >> 8) & 15, dg = i >> 12;
    float s = 0.f;
#pragma unroll 8
    for (int pp = 0; pp < 64; ++pp) { const float2 pv = pw[(dg * 64 + pp) * 17 + d]; const float cr = p.c_re[(dg * 16 + hp) * 64 + pp], ci = p.c_im[(dg * 16 + hp) * 64 + pp];
      const float2 bb = bbar[(dg * 64 + pp) * 16 + h]; const float xr = cr * pv.x - ci * pv.y, xi = cr * pv.y + ci * pv.x; s += xr * bb.x - xi * bb.y; }
    Kt[i] = s; }
  for (size_t i8 = gid; i8 < (size_t)32 * 256 * 256 / 8; i8 += gsz) { const size_t i = i8 * 8; const int k = i & 255, n = (i >> 8) & 255, g = i >> 16; const int s = k >> 4, h = k & 15, dirS = n >> 7, pp = (n >> 1) & 63, ri = n & 1;
    const int dg = dirS * 32 + g, e = dirS ? s : 15 - s; const float2 pv = pw[(dg * 64 + pp) * 17 + e]; const float2* bb = bbar + (dg * 64 + pp) * 16 + h; float v[8];
#pragma unroll
    for (int q = 0; q < 8; ++q) { const float2 b_ = bb[q]; v[q] = ri ? (pv.x * b_.y + pv.y * b_.x) : (pv.x * b_.x - pv.y * b_.y); }
    u32x4 w = {cvtpk(v[0], v[1]), cvtpk(v[2], v[3]), cvtpk(v[4], v[5]), cvtpk(v[6], v[7])}; *(u32x4*)(WS + i) = w; }
}
__device__ __forceinline__ void build_tables_p2(const P& p) {
  const size_t gid = blockIdx.x * 512ull + threadIdx.x, gsz = gridDim.x * 512ull;
  const float2* pw = WSP(float2, O_PW); const float* Kt = WSP(float, O_KT); bf16* Msg = WSP(bf16, O_MSG);
  for (size_t i8 = gid; i8 < (size_t)32 * 256 * 512 / 8; i8 += gsz) { const size_t i = i8 * 8; const int k = i & 511, n = (i >> 9) & 255, g = i >> 17; const int t = n >> 4, hp = n & 15; float v[8];
    if (k < 256) { const int s = k >> 4, h = k & 15, o = hp * 16 + h;
      if (s != t) { const float* kt = (s < t) ? Kt + ((size_t)g * 16 + (t - s)) * 256 + o : Kt + ((size_t)(32 + g) * 16 + (s - t)) * 256 + o;
        const f32x4v a = *(const f32x4v*)kt, b = *(const f32x4v*)(kt + 4);
        v[0] = a[0]; v[1] = a[1]; v[2] = a[2]; v[3] = a[3]; v[4] = b[0]; v[5] = b[1]; v[6] = b[2]; v[7] = b[3]; }
      else { const float* k0 = Kt + ((size_t)g * 16) * 256 + o; const float* k1 = Kt + ((size_t)(32 + g) * 16) * 256 + o;
        const f32x4v a = *(const f32x4v*)k0, b = *(const f32x4v*)(k0 + 4), c = *(const f32x4v*)k1, d = *(const f32x4v*)(k1 + 4);
        v[0] = a[0] + c[0]; v[1] = a[1] + c[1]; v[2] = a[2] + c[2]; v[3] = a[3] + c[3]; v[4] = b[0] + d[0]; v[5] = b[1] + d[1]; v[6] = b[2] + d[2]; v[7] = b[3] + d[3]; }
    } else { const int kk = k - 256, dirX = kk >> 7, pp0 = (kk >> 1) & 63, dg = dirX * 32 + g, e = dirX ? 16 - t : t + 1;
#pragma unroll
      for (int q = 0; q < 4; ++q) { const int pp = pp0 + q; const float2 pv = pw[(dg * 64 + pp) * 17 + e]; const float cr = p.c_re[(dg * 16 + hp) * 64 + pp], ci = p.c_im[(dg * 16 + hp) * 64 + pp];
        v[2 * q] = cr * pv.x - ci * pv.y; v[2 * q + 1] = -(cr * pv.y + ci * pv.x); } }
    u32x4 w = {cvtpk(v[0], v[1]), cvtpk(v[2], v[3]), cvtpk(v[4], v[5]), cvtpk(v[6], v[7])}; *(u32x4*)(Msg + i) = w; }
}
constexpr int NT_SSMS = 256, NT_SSMY = 512;
__device__ __forceinline__ void phase_ssmS(const P& p, int tile, char* lds) {
  const int g = tile >> 3, mt = tile & 7, m0 = mt * 256;
  f32x16 acc[4][2]; ALBn al{WSP(bf16, O_SUG) + (size_t)g * RP * GH, 256, 2047};
  gemm_main<256, 256, 64, 2, 4, -1>(lds, al, m0, WSP(bf16, O_WS) + (size_t)g * 65536, 256, 0, 255, 256, acc);
  const int tid_ = otid(), lane = tid_ & 63, wid = tid_ >> 6, wm = wid >> 2, wn = wid & 3, r32 = lane & 31, hi = lane >> 5;
  float* S = WSP(float, O_S) + (size_t)g * 2048 * 256;
#pragma unroll
  for (int i = 0; i < 4; ++i)
#pragma unroll
    for (int j = 0; j < 2; ++j)
#pragma unroll
      for (int q = 0; q < 4; ++q) { f32x4v t4 = {acc[i][j][4 * q], acc[i][j][4 * q + 1], acc[i][j][4 * q + 2], acc[i][j][4 * q + 3]};
        *(f32x4v*)(S + (size_t)(m0 + wm * 128 + i * 32 + r32) * 256 + wn * 64 + j * 32 + 8 * q + 4 * hi) = t4; }
  __syncthreads();
}
struct ALU3 { const bf16* u; const bf16* xa; using Raw = u32x4;
  __device__ __forceinline__ Raw load(int m, int k) const { return *(const u32x4*)(k < 256 ? u + (size_t)m * 256 + k : xa + (size_t)m * 256 + (k - 256)); }
  __device__ __forceinline__ bf16x8 cvt(const Raw& v, int k, float& ss) const { return (bf16x8)v; } };
__device__ __forceinline__ void phase_ssmY(const P& p, int tile, char* lds) {
  const int g = tile >> 4, mt = (tile >> 1) & 7, nt = tile & 1, m0 = mt * 256, n0 = nt * 128;
  const bf16* ug = WSP(bf16, O_SUG) + (size_t)g * RP * GH;
  f32x16 acc[2][2]; ALU3 al{ug, WSP(bf16, O_XA) + (size_t)g * 2048 * 256};
  gemm_main<256, 128, 64, 4, 2, -1>(lds, al, m0, WSP(bf16, O_MSG) + (size_t)g * 256 * 512, 512, n0, 255, 512, acc);
  const int tid_ = otid(), lane = tid_ & 63, wid = tid_ >> 6, wm = wid >> 1, wn = wid & 1, r32 = lane & 31, hi = lane >> 5;
  bf16* ysg = WSP(bf16, O_YSG);
#pragma unroll
  for (int i = 0; i < 2; ++i)
#pragma unroll
    for (int j = 0; j < 2; ++j) { const int m = m0 + wm * 64 + i * 32 + r32;
#pragma unroll
      for (int q = 0; q < 4; ++q) { const int n = n0 + wn * 64 + j * 32 + 8 * q + 4 * hi, t = n >> 4, hp = n & 15;
        const f32x4v dd = *(const f32x4v*)(p.ssm_d + g * 16 + hp); const uint2 uw = *(const uint2*)(ug + (size_t)m * 256 + n);
        const float y0 = acc[i][j][4 * q] + dd[0] * bflo(uw.x), y1 = acc[i][j][4 * q + 1] + dd[1] * bfhi(uw.x), y2 = acc[i][j][4 * q + 2] + dd[2] * bflo(uw.y), y3 = acc[i][j][4 * q + 3] + dd[3] * bfhi(uw.y);
        *(uint2*)(ysg + ((size_t)m * 16 + t) * DS + g * 16 + hp) = pack4(gelu_tanh(y0), gelu_tanh(y1), gelu_tanh(y2), gelu_tanh(y3)); } }
  __syncthreads();
}
__device__ __forceinline__ float2 cmul(float2 a, float2 b) { return make_float2(a.x * b.x - a.y * b.y, a.x * b.y + a.y * b.x); }
__device__ __forceinline__ float2 cfma(float2 a, float2 x, float2 s) { return make_float2(a.x * x.x - a.y * x.y + s.x, a.x * x.y + a.y * x.x + s.y); }
__device__ __forceinline__ void phase_carry1(const P& p) {
  const int nthr = 2 * 32 * 2 * 32 * 64; const float2* pw = WSP(float2, O_PW); float2* E = WSP(float2, O_E);
  for (int idx = blockIdx.x * 512 + threadIdx.x; idx < nthr; idx += gridDim.x * 512) {
    const int pp = idx & 63, sc = (idx >> 6) & 31, dir = (idx >> 11) & 1, g = (idx >> 12) & 31, b = idx >> 17;
    const float2 a16 = pw[((dir * 32 + g) * 64 + pp) * 17 + 16];
    const float* S = WSP(float, O_S) + ((size_t)g * 2048 + b * 1024) * 256 + dir * 128 + pp * 2; float2 X = make_float2(0.f, 0.f);
    for (int q = 0; q < 32; ++q) { const int c = sc * 32 + (dir ? 31 - q : q); const float2 s = *(const float2*)(S + (size_t)c * 256); X = cfma(a16, X, s); }
    E[idx] = X; }
}
__device__ __forceinline__ void phase_carry2(const P& p) {
  const int nthr = 2 * 32 * 2 * 32 * 64; const float2* pw = WSP(float2, O_PW); const float2* E = WSP(float2, O_E); const float2* bbar = WSP(float2, O_BBAR);
  for (int idx = blockIdx.x * 512 + threadIdx.x; idx < nthr; idx += gridDim.x * 512) {
    const int pp = idx & 63, sc = (idx >> 6) & 31, dir = (idx >> 11) & 1, g = (idx >> 12) & 31, b = idx >> 17;
    const int dgp = (dir * 32 + g) * 64 + pp; const float2 a16 = pw[dgp * 17 + 16];
    float2 a512 = a16;
#pragma unroll
    for (int q = 0; q < 5; ++q) a512 = cmul(a512, a512);
    float2 X = make_float2(0.f, 0.f); const float2* Eb = E + (idx & ~(31 << 6) & ~63) + pp;
    if (dir == 0) {
      const bf16* um = WSP(bf16, O_SUG) + ((size_t)g * RP + RX) * GH;
      for (int s = 0; s < 16; ++s) { float2 bu = make_float2(0.f, 0.f);
        for (int h = 0; h < 16; ++h) { const float u = bf2f(um[s * 16 + h]); const float2 bb = bbar[dgp * 16 + h]; bu.x += bb.x * u; bu.y += bb.y * u; }
        X = cfma(pw[dgp * 17 + 1], X, bu); }
      for (int j = 0; j < sc; ++j) X = cfma(a512, X, Eb[j * 64]);
    } else {
      for (int j = 31; j > sc; --j) X = cfma(a512, X, Eb[j * 64]);
    }
    const float* S = WSP(float, O_S) + ((size_t)g * 2048 + b * 1024) * 256 + dir * 128 + pp * 2;
    bf16* XA = WSP(bf16, O_XA) + ((size_t)g * 2048 + b * 1024) * 256 + dir * 128 + pp * 2;
    for (int q = 0; q < 32; ++q) { const int c = sc * 32 + (dir ? 31 - q : q);
      *(unsigned*)(XA + (size_t)c * 256) = cvtpk(X.x, X.y);
      const float2 s = *(const float2*)(S + (size_t)c * 256); X = cfma(a16, X, s); }
  }
}


#define XB_TMO      128
#define XB_XCNT(j)  (256  + 64 * (j))
#define XB_XSUB(j)  (1280 + 64 * (j))
#define XB_XGEN(j)  (2304 + 64 * (j))
#define XB_TOP      3328
#define XB_TOPGEN   3392
#define XCD_BAR_WORDS 3456
#define XB_SPIN_CAP (1u << 22)
#define LAS __attribute__((address_space(3)))
__device__ __forceinline__ unsigned xb_ld(unsigned* p)              { return __hip_atomic_load(p, __ATOMIC_RELAXED, __HIP_MEMORY_SCOPE_AGENT); }
__device__ __forceinline__ unsigned xb_add(unsigned* p, unsigned v) { return __hip_atomic_fetch_add(p, v, __ATOMIC_RELAXED, __HIP_MEMORY_SCOPE_AGENT); }
__device__ __forceinline__ unsigned xb_xcc_id() { return (unsigned)__builtin_amdgcn_s_getreg((3 << 11) | 20) & 0xFu; }
#define XB_SPIN(cond, bar) do { unsigned _sp = 0; while (cond) { __builtin_amdgcn_s_sleep(1); \
    if ((++_sp & 255u) == 0u) { if (xb_ld(&(bar)[XB_TMO])) break; if (_sp > XB_SPIN_CAP) { atomicAdd(&(bar)[XB_TMO], 1u); break; } } } } while (0)
struct XcdBarrier { unsigned* bar; unsigned x; volatile LAS unsigned* st; };
__device__ __forceinline__ XcdBarrier xcd_barrier_post(unsigned* bar, volatile LAS unsigned* st) {
  XcdBarrier b; b.bar = bar; b.x = xb_xcc_id(); b.st = st;
  if (threadIdx.x == 0) (void)xb_add(&bar[XB_XCNT(b.x)], 1u);
  return b;
}
__device__ __forceinline__ void xcd_barrier_complete(unsigned* bar, unsigned x, unsigned& nloc, unsigned& nx) {
  const unsigned G = gridDim.x * gridDim.y * gridDim.z; unsigned sum, cnt, mine, sp = 0u;
  for (;;) {
    sum = 0u; cnt = 0u; mine = 0u;
#pragma unroll
    for (unsigned j = 0; j < 16; ++j) { const unsigned c = xb_ld(&bar[XB_XCNT(j)]); sum += c; cnt += (c > 0u) ? 1u : 0u; mine = (j == x) ? c : mine; }
    if (sum == G) break;
    __builtin_amdgcn_s_sleep(1);
    if ((++sp & 255u) == 0u) { if (xb_ld(&bar[XB_TMO])) break; if (sp > XB_SPIN_CAP) { atomicAdd(&bar[XB_TMO], 1u); break; } }
  }
  nloc = mine > 0u ? mine : 1u; nx = cnt > 0u ? cnt : 1u;
}
__device__ __forceinline__ void xcd_barrier(const XcdBarrier& b) {
  asm volatile("s_waitcnt vmcnt(0)" ::: "memory");
  __syncthreads();
  if (threadIdx.x == 0) {
    unsigned* bar = b.bar;
    __builtin_amdgcn_s_waitcnt(0);
    unsigned nloc = b.st[0], nx = b.st[1];
    if (nloc == 0u) { xcd_barrier_complete(bar, b.x, nloc, nx); b.st[0] = nloc; b.st[1] = nx; }
    const unsigned old = xb_add(&bar[XB_XSUB(b.x)], 1u);
    const unsigned gen = old / nloc;
    if (old + 1u == (gen + 1u) * nloc) {
      __builtin_amdgcn_fence(__ATOMIC_RELEASE, "agent");
      asm volatile("s_waitcnt vmcnt(0)" ::: "memory");
      const unsigned og = xb_add(&bar[XB_TOP], 1u);
      const unsigned tg = og / nx;
      if (og + 1u == (tg + 1u) * nx) xb_add(&bar[XB_TOPGEN], 1u);
      else XB_SPIN(xb_ld(&bar[XB_TOPGEN]) == tg, bar);
      __builtin_amdgcn_fence(__ATOMIC_ACQUIRE, "agent");
      xb_add(&bar[XB_XGEN(b.x)], 1u);
      asm volatile("s_waitcnt vmcnt(0)" ::: "memory");
    } else {
      XB_SPIN(xb_ld(&bar[XB_XGEN(b.x)]) == gen, bar);
      __builtin_amdgcn_fence(__ATOMIC_ACQUIRE, "agent");
      asm volatile("s_waitcnt vmcnt(0)" ::: "memory");
    }
  }
  __syncthreads();
}

__global__ void __launch_bounds__(512) k_mega(P p) {
  __shared__ __attribute__((aligned(16))) char lds[LDS_BYTES];
  cg::grid_group grid = cg::this_grid();
  __shared__ uint4 xb_words;
  if (threadIdx.x == 0) xb_words = make_uint4(0u, 0u, 0u, 0u);
  __syncthreads();
  XcdBarrier xbar = xcd_barrier_post(WSP(unsigned, O_BAR), (volatile LAS unsigned*)&xb_words);
#define GSYNC() do { for (int q_ = 0; q_ < REP_SYNC; ++q_) xcd_barrier(xbar); } while (0)
  prep_all(p, lds);
  grid.sync();
  build_tables_p1(p);
  for (int rep = 0; rep < REP_INPROJ; ++rep) for (int t = blockIdx.x; t < NT_INPROJ; t += gridDim.x) phase_inproj(p, t, lds);
  GSYNC();
  build_tables_p2(p);
  for (int rep = 0; rep < REP_P2; ++rep)
  for (int t = blockIdx.x; t < NT_QUP + NT_KVUP + NT_SSMS; t += gridDim.x) { if (t < NT_QUP) phase_qup(p, t, lds); else if (t < NT_QUP + NT_KVUP) phase_kvup(p, t - NT_QUP, lds); else phase_ssmS(p, t - NT_QUP - NT_KVUP, lds); }
  GSYNC();
  phase_carry1(p);
  GSYNC();
  phase_carry2(p);
  GSYNC();
  for (int rep = 0; rep < REP_ATTN; ++rep)
  for (int t = blockIdx.x; t < NT_ATTN + NT_SSMY; t += gridDim.x) { if (t < NT_ATTN) attn_item<true>(p, t, lds); else phase_ssmY(p, t - NT_ATTN, lds); }
  GSYNC();
  for (int rep = 0; rep < REP_GLU; ++rep) for (int t = blockIdx.x; t < NT_GLU; t += gridDim.x) phase_glu(p, t, lds);
  GSYNC();
  for (int rep = 0; rep < REP_OUT; ++rep) for (int t = blockIdx.x; t < NT_OUT; t += gridDim.x) phase_out(p, t, lds);
  GSYNC();
  for (int rep = 0; rep < REP_FIN; ++rep) phase_final(p);
}

extern "C" void kernel_launch(void* const* d_in, const int* in_sizes, int n_in, void* d_out, int out_size, void* d_ws, size_t ws_size, hipStream_t stream) {
  P p{};
  const float** f = (const float**)&p;
  for (int i = 0; i < 22; ++i) f[i] = (const float*)d_in[i];
  p.out = (float*)d_out; p.ws = (char*)d_ws;
  if (ws_size < O_END) { fprintf(stderr, "ws too small\n"); return; }
  static int grid_blocks = 0;
  if (!grid_blocks) {
    int dev = 0, cus = 0, per_cu = 0; hipGetDevice(&dev);
    hipDeviceGetAttribute(&cus, hipDeviceAttributeMultiprocessorCount, dev);
    hipOccupancyMaxActiveBlocksPerMultiprocessor(&per_cu, k_mega, 512, 0);
    if (per_cu < 1) per_cu = 1;
    grid_blocks = cus * per_cu;
  }
  hipMemsetAsync((char*)d_ws + O_BAR, 0, 4096 * 4, stream);
  void* args[] = {&p};
  hipError_t e = hipLaunchCooperativeKernel((void*)k_mega, dim3(grid_blocks), dim3(512), args, 0, stream);
  if (e != hipSuccess) fprintf(stderr, "cooperative launch failed: %s (grid %d)\n", hipGetErrorString(e), grid_blocks);
}
```

```cpp
#include <hip/hip_runtime.h>
#include <hip/hip_bf16.h>
#include <hip/hip_cooperative_groups.h>
#include <cstdio>
namespace cg = cooperative_groups;
#include <stdint.h>
typedef __hip_bfloat16 bf16;
#ifndef REP_ATTN
#define REP_ATTN 1
#endif
#ifndef REP_INPROJ
#define REP_INPROJ 1
#endif
#ifndef REP_TAIL
#define REP_TAIL 1
#endif
#ifndef REP_P2
#define REP_P2 1
#endif
#ifndef REP_GLU
#define REP_GLU 1
#endif
#ifndef REP_OUT
#define REP_OUT 1
#endif
#ifndef REP_FIN
#define REP_FIN 1
#endif
#ifndef REP_SYNC
#define REP_SYNC 1
#endif

constexpr int DM = 1024, SEQ = 16384, NB = 2, NMETA = 16, LTOT = SEQ + NMETA;
constexpr int DIN = 1952, QL = 256, KVL = 128, QR = 32, DA = 512, DS = 512;
constexpr int NH = 8, DQK = 96, DV = 64, NG = 32, GH = 16, NP = 64;
constexpr int RX = NB * SEQ;
constexpr int RT = RX + NMETA;
constexpr int RP = 33024;
constexpr int KPAD = 48;
constexpr int NKEY = LTOT + KPAD;
constexpr float EPS = 1e-6f;
constexpr int LDK = DM + 64;

constexpr size_t al(size_t x) { return (x + 255) / 256 * 256; }
constexpr size_t O_WTIN = 0;
constexpr size_t O_WTQ = O_WTIN + al((size_t)DIN * LDK * 2);
constexpr size_t O_WTKV = O_WTQ + al((size_t)768 * QL * 2);
constexpr size_t O_WTGLU = O_WTKV + al((size_t)1024 * KVL * 2);
constexpr size_t O_WTOUT = O_WTGLU + al((size_t)1024 * DS * 2);
constexpr size_t O_BGLU = O_WTOUT + al((size_t)DM * DM * 2);
constexpr size_t O_ROPE = O_BGLU + al(1024 * 4);
constexpr size_t O_ABAR = O_ROPE + al((size_t)LTOT * 16 * 8);
constexpr size_t O_BBAR = O_ABAR + al(2 * 32 * 64 * 8);
constexpr size_t O_QLAT = O_BBAR + al(2 * 32 * 64 * 16 * 8);
constexpr size_t O_KVLAT = O_QLAT + al((size_t)RP * QL * 2);
constexpr size_t O_AGATE = O_KVLAT + al((size_t)RP * KVL * 2);
constexpr size_t O_SGATE = O_AGATE + al((size_t)RX * DA * 2);
constexpr size_t O_SUG = O_SGATE + al((size_t)RX * DS * 2);
constexpr size_t O_KN = O_SUG + al((size_t)NG * RP * GH * 2);
constexpr size_t O_V = O_KN + al((size_t)NB * NH * NKEY * 64 * 2);
constexpr size_t O_KR = O_V + al((size_t)NB * NH * NKEY * 64 * 2);
constexpr size_t O_Q = O_KR + al((size_t)NB * NKEY * 32 * 2);
constexpr size_t O_YA = O_Q + al((size_t)NB * NH * SEQ * DQK * 2);
constexpr size_t O_YSG = O_YA + al((size_t)RX * DA * 2);
constexpr size_t O_YSN = O_YSG + al((size_t)RX * DS * 2);
constexpr size_t O_RSX = O_YSN + al((size_t)RX * DS * 2);
constexpr size_t O_RSQ = O_RSX + al(RP * 4);
constexpr size_t O_RSKV = O_RSQ + al(RP * 4);
constexpr size_t O_RSA = O_RSKV + al(RP * 4);
constexpr size_t O_PW = O_RSA + al(RP * 4);
constexpr size_t O_KT = O_PW + al(2 * 32 * 64 * 17 * 8);
constexpr size_t O_WS = O_KT + al(2 * 32 * 16 * 256 * 4);
constexpr size_t O_MSG = O_WS + al((size_t)32 * 256 * 256 * 2);
constexpr size_t O_S = O_MSG + al((size_t)32 * 256 * 512 * 2);
constexpr size_t O_XB = O_S;
constexpr size_t O_E = O_S + al((size_t)RP * LDK * 2);
constexpr size_t O_XA = O_E + al((size_t)2 * 32 * 2 * 32 * 64 * 8);
constexpr size_t O_BAR = O_XA + al((size_t)32 * 2048 * 256 * 2);
constexpr size_t O_GPART = O_BAR + al(4096 * 4);
constexpr size_t O_YPART = O_GPART + al((size_t)16 * RX * 4);
constexpr size_t O_Y = O_S;
constexpr size_t O_END = O_YPART + al((size_t)16 * RX * 4);

struct P {
  const float *x, *meta, *pre_w, *post_w, *w_in, *qn_w, *w_qup, *kvn_w, *w_kvup, *aon_w;
  const float *a_re, *a_im, *log_dt, *b_re, *b_im, *c_re, *c_im, *ssm_d, *w_glu, *b_glu, *son_w, *w_out;
  float* out; char* ws;
};
#define WSP(T, off) ((T*)(p.ws + (off)))

__device__ __forceinline__ float bf2f(bf16 v) { return __bfloat162float(v); }
__device__ __forceinline__ bf16 f2bf(float v) { return __float2bfloat16(v); }
__device__ __forceinline__ float silu(float v) { return v / (1.f + __expf(-v)); }
__device__ __forceinline__ float gelu_tanh(float v) {
  const float u = 0.7978845608028654f * (v + 0.044715f * v * v * v);
  return v / (1.f + __expf(-2.f * u));
}
__device__ __forceinline__ const float* xrow(const P& p, int r) {
  return r < RX ? p.x + (size_t)r * DM : p.meta + (size_t)(r - RX) * DM;
}
__device__ __forceinline__ void sincos_red(double ang, float& c, float& s) {
  const double TWO_PI = 6.283185307179586476925;
  double n = rint(ang / TWO_PI); float r = (float)(ang - n * TWO_PI);
  c = cosf(r); s = sinf(r);
}

using bf16x8 = __attribute__((ext_vector_type(8))) short;
using f32x16 = __attribute__((ext_vector_type(16))) float;
using f32x4v = __attribute__((ext_vector_type(4))) float;
using u32x4 = __attribute__((ext_vector_type(4))) unsigned;
__device__ __forceinline__ int otid() { int t = threadIdx.x; asm volatile("" : "+v"(t)); return t; }
__device__ __forceinline__ int crow(int r, int hi) { return (r & 3) + 8 * (r >> 2) + 4 * hi; }
__device__ __forceinline__ unsigned cvtpk(float lo, float hi) { unsigned r; asm("v_cvt_pk_bf16_f32 %0, %1, %2" : "=v"(r) : "v"(lo), "v"(hi)); return r; }
__device__ __forceinline__ float bflo(unsigned u) { return __uint_as_float(u << 16); }
__device__ __forceinline__ float bfhi(unsigned u) { return __uint_as_float(u & 0xffff0000u); }
__device__ __forceinline__ void stbf(bf16* dst, float v) { *(unsigned short*)dst = (unsigned short)(cvtpk(v, v) & 0xffffu); }

__device__ __forceinline__ void prep_transposes(const P& p, char* lds) {
  float* T = (float*)lds; const int tid = threadIdx.x;
  constexpr int T_IN = 16 * 31, T_OUT = 16 * 16, T_GLU = 8 * 16, T_Q = 4 * 12, T_KV = 2 * 16, T_ALL = T_IN + T_OUT + T_GLU + T_Q + T_KV;
  for (int t = blockIdx.x; t < T_ALL; t += gridDim.x) {
    const float* W; const float* g0; const float* g1 = nullptr; bf16* dst; int N, ldk, kt, nt_, which;
    if (t < T_IN) { which = 0; W = p.w_in; g0 = p.pre_w; dst = WSP(bf16, O_WTIN); N = DIN; ldk = LDK; kt = t / 31; nt_ = t % 31; }
    else if (t < T_IN + T_OUT) { const int u = t - T_IN; which = 1; W = p.w_out; g0 = p.aon_w; g1 = p.son_w; dst = WSP(bf16, O_WTOUT); N = DM; ldk = DM; kt = u >> 4; nt_ = u & 15; }
    else if (t < T_IN + T_OUT + T_GLU) { const int u = t - T_IN - T_OUT; which = 2; W = p.w_glu; g0 = nullptr; dst = WSP(bf16, O_WTGLU); N = 1024; ldk = DS; kt = u >> 4; nt_ = u & 15; }
    else if (t < T_IN + T_OUT + T_GLU + T_Q) { const int u = t - T_IN - T_OUT - T_GLU; which = 3; W = p.w_qup; g0 = p.qn_w; dst = WSP(bf16, O_WTQ); N = 768; ldk = QL; kt = u / 12; nt_ = u % 12; }
    else { const int u = t - T_IN - T_OUT - T_GLU - T_Q; which = 4; W = p.w_kvup; g0 = p.kvn_w; dst = WSP(bf16, O_WTKV); N = 1024; ldk = KVL; kt = u >> 4; nt_ = u & 15; }
    const int k0 = kt * 64, n0 = nt_ * 64;
#pragma unroll
    for (int i = 0; i < 8; ++i) { const int kk = (tid >> 6) + 8 * i, nn = tid & 63, k = k0 + kk, n = n0 + nn;
      float gk = 1.f; if (which == 1) gk = k < 512 ? g0[k] : g1[k - 512]; else if (g0) gk = g0[k];
      T[kk * 65 + nn] = (n < N) ? W[(size_t)k * N + n] * gk : 0.f; }
    __syncthreads();
    { const int nn = tid >> 3, kc = tid & 7, n = n0 + nn;
      if (n < N) { int row = n; if (which == 2) row = n < 512 ? ((n >> 5) * 64 + (n & 31)) : (((n - 512) >> 5) * 64 + 32 + (n & 31));
        float v[8];
#pragma unroll
        for (int e = 0; e < 8; ++e) v[e] = T[(kc * 8 + e) * 65 + nn];
        u32x4 w = {cvtpk(v[0], v[1]), cvtpk(v[2], v[3]), cvtpk(v[4], v[5]), cvtpk(v[6], v[7])};
        *(u32x4*)(dst + (size_t)row * ldk + k0 + kc * 8) = w; } }
    __syncthreads();
  }
}
__device__ __forceinline__ void prep_all(const P& p, char* lds) {
  const size_t gid = blockIdx.x * (size_t)blockDim.x + threadIdx.x, gsz = gridDim.x * (size_t)blockDim.x;
  prep_transposes(p, lds);
  { float* bglu = WSP(float, O_BGLU);
    for (size_t i = gid; i < 1024; i += gsz) { const int sc = (int)i; const int n = sc < 512 ? ((sc >> 5) * 64 + (sc & 31)) : (((sc - 512) >> 5) * 64 + 32 + (sc & 31)); bglu[n] = p.b_glu[sc]; } }
  { const int lane = threadIdx.x & 63; bf16* xb = WSP(bf16, O_XB); float* rsx = WSP(float, O_RSX);
    for (size_t row = gid >> 6; row < (size_t)RT; row += gsz >> 6) { const float* xr = xrow(p, (int)row); float ss = 0.f;
#pragma unroll
      for (int q = 0; q < 4; ++q) { const f32x4v v = *(const f32x4v*)(xr + q * 256 + lane * 4); ss += v[0] * v[0] + v[1] * v[1] + v[2] * v[2] + v[3] * v[3];
        uint2 w; w.x = cvtpk(v[0], v[1]); w.y = cvtpk(v[2], v[3]); *(uint2*)(xb + row * LDK + q * 256 + lane * 4) = w; }
#pragma unroll
      for (int o = 32; o > 0; o >>= 1) ss += __shfl_xor(ss, o);
      if (lane == 0) rsx[row] = rsqrtf(ss * (1.f / DM) + EPS); } }
  float2* rope = WSP(float2, O_ROPE);
  for (size_t i = gid; i < (size_t)LTOT * 16; i += gsz) {
    int pos = i / 16, j = i % 16; float inv = powf(10000.f, -(float)j / 16.f); float ang = (float)pos * inv;
    float c, s; sincos_red((double)ang, c, s); rope[i] = make_float2(c, s); }
  float2* abar = WSP(float2, O_ABAR); float2* bbar = WSP(float2, O_BBAR);
  for (size_t i = gid; i < 2 * 32 * 64; i += gsz) {
    int dg = i / 64; double dt = exp((double)p.log_dt[dg]); double are = p.a_re[i], aim = p.a_im[i];
    double mag = exp(are * dt); float c, s; sincos_red(aim * dt, c, s);
    double br = mag * (double)c, bi = mag * (double)s;
    br = mag * cos(aim * dt); bi = mag * sin(aim * dt);
    abar[i] = make_float2((float)br, (float)bi);
    { float2* pw = WSP(float2, O_PW) + i * 17;
      double pr = 1.0, pi_ = 0.0;
      for (int d = 0; d <= 16; ++d) { pw[d] = make_float2((float)pr, (float)pi_); const double nr_ = pr * br - pi_ * bi, ni_ = pr * bi + pi_ * br; pr = nr_; pi_ = ni_; } }
    double nr = br - 1.0, ni = bi, den = are * are + aim * aim;
    double cr = (nr * are + ni * aim) / den, ci = (ni * are - nr * aim) / den;
    for (int h = 0; h < 16; ++h) { double b_r = p.b_re[i * 16 + h], b_i = p.b_im[i * 16 + h];
      bbar[i * 16 + h] = make_float2((float)(cr * b_r - ci * b_i), (float)(cr * b_i + ci * b_r)); }
  }
  bf16* kn = WSP(bf16, O_KN); bf16* vv = WSP(bf16, O_V); bf16* kr = WSP(bf16, O_KR);
  for (size_t i = gid; i < (size_t)NB * NH * KPAD * 64; i += gsz) { size_t bh = i / (KPAD * 64), rem = i % (KPAD * 64); kn[bh * NKEY * 64 + rem] = f2bf(0.f); vv[bh * NKEY * 64 + rem] = f2bf(0.f); }
  for (size_t i = gid; i < (size_t)NB * KPAD * 32; i += gsz) { size_t b = i / (KPAD * 32), rem = i % (KPAD * 32); kr[b * NKEY * 32 + rem] = f2bf(0.f); }
}

template <int RB> __device__ __forceinline__ int swz(int row, int chunk) { return row * RB + ((chunk ^ ((row / (256 / RB)) & (RB / 16 - 1))) << 4); }

constexpr int LDS_ROWSS = 131072;
constexpr int LDS_RED = LDS_ROWSS + 1024;
constexpr int LDS_BYTES = LDS_RED + 2048;

struct ALX {
  const float* x; const float* meta;
  struct Raw { f32x4v a, b; };
  __device__ __forceinline__ Raw load(int m, int k) const { m = m < RT ? m : RT - 1;
    const float* r = (m < RX ? x + (size_t)m * DM : meta + (size_t)(m - RX) * DM) + k; Raw v; v.a = *(const f32x4v*)r; v.b = *(const f32x4v*)(r + 4); return v; }
  __device__ __forceinline__ bf16x8 cvt(const Raw& v, int k, float& ss) const {
    ss += v.a[0] * v.a[0] + v.a[1] * v.a[1] + v.a[2] * v.a[2] + v.a[3] * v.a[3] + v.b[0] * v.b[0] + v.b[1] * v.b[1] + v.b[2] * v.b[2] + v.b[3] * v.b[3];
    u32x4 w = {cvtpk(v.a[0], v.a[1]), cvtpk(v.a[2], v.a[3]), cvtpk(v.b[0], v.b[1]), cvtpk(v.b[2], v.b[3])}; return (bf16x8)w; }
};
__device__ __forceinline__ float ss8(u32x4 v) { float s = 0.f;
#pragma unroll
  for (int j = 0; j < 4; ++j) { float a = bflo(v[j]), b = bfhi(v[j]); s += a * a + b * b; } return s; }
struct ALB {
  const bf16* a; int ld; int mmax; using Raw = u32x4;
  __device__ __forceinline__ Raw load(int m, int k) const { m = m < mmax ? m : mmax; return *(const u32x4*)(a + (size_t)m * ld + k); }
  __device__ __forceinline__ bf16x8 cvt(const Raw& v, int k, float& ss) const { ss += ss8(v); return (bf16x8)v; }
};
struct ALBn {
  const bf16* a; int ld; int mmax; using Raw = u32x4;
  __device__ __forceinline__ Raw load(int m, int k) const { m = m < mmax ? m : mmax; return *(const u32x4*)(a + (size_t)m * ld + k); }
  __device__ __forceinline__ bf16x8 cvt(const Raw& v, int k, float& ss) const { return (bf16x8)v; }
};
struct ALOut {
  const bf16* ya; const bf16* ysn; using Raw = u32x4;
  __device__ __forceinline__ Raw load(int m, int k) const { return *(const u32x4*)(k < 512 ? ya + (size_t)m * 512 + k : ysn + (size_t)m * 512 + (k - 512)); }
  __device__ __forceinline__ bf16x8 cvt(const Raw& v, int k, float& ss) const { if (k < 512) ss += ss8(v); return (bf16x8)v; }
};

template <int BM, int BN, int BK, int WGM, int WGN, int MIDKT, class AL>
__device__ __forceinline__ void gemm_main(char* lds, const AL& al, int m0, const bf16* __restrict__ Bt, int ldb, int n0, int nmax, int K,
                                          f32x16 (&acc)[BM / WGM / 32][BN / WGN / 32], const float* midsc = nullptr) {
  constexpr int CPR = BK / 8, RB = BK * 2, RPS = 512 / CPR, A_CH = (BM + RPS - 1) / RPS, B_CH = BN / RPS;
  constexpr int TM = BM / WGM / 32, TN = BN / WGN / 32, A_BYTES = BM * RB, STAGE = (BM + BN) * RB;
  const int tid = otid(), lane = tid & 63, wid = tid >> 6, wm = wid / WGN, wn = wid % WGN, r32 = lane & 31, hi = lane >> 5;
  const int srow = tid / CPR, sch = tid % CPR;
  float* rowss = (float*)(lds + LDS_ROWSS);
  typename AL::Raw ra[A_CH]; u32x4 rb[B_CH]; float ss[A_CH];
#pragma unroll
  for (int i = 0; i < A_CH; ++i) ss[i] = 0.f;
#pragma unroll
  for (int i = 0; i < TM; ++i)
#pragma unroll
    for (int j = 0; j < TN; ++j)
#pragma unroll
      for (int r = 0; r < 16; ++r) acc[i][j][r] = 0.f;
#define GLOAD(kt) do { const int k_ = (kt) * BK + sch * 8; \
    _Pragma("unroll") for (int i = 0; i < A_CH; ++i) if (BM % RPS == 0 || srow + i * RPS < BM) ra[i] = al.load(m0 + srow + i * RPS, k_); \
    _Pragma("unroll") for (int i = 0; i < B_CH; ++i) { int n_ = n0 + srow + i * RPS; n_ = n_ < nmax ? n_ : nmax; rb[i] = *(const u32x4*)(Bt + (size_t)n_ * ldb + k_); } } while (0)
#define SWRITE(buf, kt) do { char* base_ = lds + (buf) * STAGE; const int k_ = (kt) * BK + sch * 8; \
    _Pragma("unroll") for (int i = 0; i < A_CH; ++i) if (BM % RPS == 0 || srow + i * RPS < BM) *(bf16x8*)(base_ + swz<RB>(srow + i * RPS, sch)) = al.cvt(ra[i], k_, ss[i]); \
    _Pragma("unroll") for (int i = 0; i < B_CH; ++i) *(u32x4*)(base_ + A_BYTES + swz<RB>(srow + i * RPS, sch)) = rb[i]; } while (0)
#define PUBSS() do { \
    _Pragma("unroll") for (int i = 0; i < A_CH; ++i) { float s_ = ss[i]; \
      _Pragma("unroll") for (int o = 1; o < CPR; o <<= 1) s_ += __shfl_xor(s_, o); \
      if (sch == 0 && (BM % RPS == 0 || srow + i * RPS < BM)) rowss[srow + i * RPS] = s_; } \
    __syncthreads(); } while (0)
  const int nk = K / BK;
  GLOAD(0); SWRITE(0, 0); __syncthreads();
#pragma unroll 1
  for (int kt = 0; kt < nk; ++kt) {
    if (kt + 1 < nk) GLOAD(kt + 1);
    if (MIDKT >= 0 && kt == MIDKT) {
      PUBSS();
#pragma unroll
      for (int i = 0; i < TM; ++i)
      { float rs = rsqrtf(rowss[wm * (TM * 32) + i * 32 + r32] * (1.f / 512.f) + EPS); if (midsc) rs *= midsc[wm * (TM * 32) + i * 32 + r32];
#pragma unroll
        for (int j = 0; j < TN; ++j)
#pragma unroll
          for (int r = 0; r < 16; ++r) acc[i][j][r] *= rs; }
    }
    const char* base = lds + (kt & 1) * STAGE;
#pragma unroll
    for (int ks = 0; ks < BK / 16; ++ks) {
      bf16x8 af[TM], bfr[TN];
#pragma unroll
      for (int i = 0; i < TM; ++i) af[i] = *(const bf16x8*)(base + swz<RB>(wm * (TM * 32) + i * 32 + r32, ks * 2 + hi));
#pragma unroll
      for (int j = 0; j < TN; ++j) bfr[j] = *(const bf16x8*)(base + A_BYTES + swz<RB>(wn * (TN * 32) + j * 32 + r32, ks * 2 + hi));
#pragma unroll
      for (int i = 0; i < TM; ++i)
#pragma unroll
        for (int j = 0; j < TN; ++j) acc[i][j] = __builtin_amdgcn_mfma_f32_32x32x16_bf16(bfr[j], af[i], acc[i][j], 0, 0, 0);
    }
    if (kt + 1 < nk) SWRITE((kt + 1) & 1, kt + 1);
    __syncthreads();
  }
  if (MIDKT < 0) PUBSS();
#undef GLOAD
#undef SWRITE
#undef PUBSS
}

__device__ __forceinline__ int row_pos(int m) { return m < RX ? (m & (SEQ - 1)) + NMETA : m - RX; }
__device__ __forceinline__ uint2 pack4(float a, float b, float c, float d) { uint2 w; w.x = cvtpk(a, b); w.y = cvtpk(c, d); return w; }
__device__ __forceinline__ void rope_block(f32x16& v, const float2* rope_pos, int hi) {
#pragma unroll
  for (int g = 0; g < 2; ++g)
#pragma unroll
    for (int e = 0; e < 4; ++e) { const int r = 4 * g + e; const float2 cs = rope_pos[8 * g + 4 * hi + e];
      const float x1 = v[r], x2 = v[r + 8]; v[r] = x1 * cs.x - x2 * cs.y; v[r + 8] = x1 * cs.y + x2 * cs.x; }
}

constexpr int NT_INPROJ = 5 * 256;
__device__ __forceinline__ void inproj_xform(const P& p, f32x16& a, int m, int nb, int hi, float rs) {
#pragma unroll
  for (int r = 0; r < 16; ++r) a[r] *= rs;
  if (nb == 384) rope_block(a, WSP(float2, O_ROPE) + row_pos(m < RT ? m : RT - 1) * 16, hi);
  else if ((nb >= 416 && nb < 928) || nb >= 1440) {
#pragma unroll
    for (int r = 0; r < 16; ++r) a[r] = silu(a[r]); }
}
constexpr int EP_RS = 144;
__device__ __forceinline__ void inproj_rows(const P& p, char* wl, f32x16& a0, f32x16& a1, int mrow0, int nb0, int lane, int r32, int hi) {
  const int m = mrow0 + r32; const float rs = WSP(float, O_RSX)[m < RT ? m : RT - 1];
  inproj_xform(p, a0, m, nb0, hi, rs); inproj_xform(p, a1, m, nb0 + 32, hi, rs);
#pragma unroll
  for (int g = 0; g < 4; ++g) {
    *(uint2*)(wl + r32 * EP_RS + (8 * g + 4 * hi) * 2) = pack4(a0[4 * g], a0[4 * g + 1], a0[4 * g + 2], a0[4 * g + 3]);
    *(uint2*)(wl + r32 * EP_RS + (32 + 8 * g + 4 * hi) * 2) = pack4(a1[4 * g], a1[4 * g + 1], a1[4 * g + 2], a1[4 * g + 3]); }
#pragma unroll
  for (int it = 0; it < 4; ++it) {
    const int row = it * 8 + (lane >> 3), ch = lane & 7, mm = mrow0 + row, n = nb0 + ch * 8;
    const u32x4 v = *(const u32x4*)(wl + row * EP_RS + ch * 16);
    if (n >= DIN || mm >= RT) continue;
    bf16* dst;
    if (n < 256) dst = WSP(bf16, O_QLAT) + (size_t)mm * QL + n;
    else if (n < 384) dst = WSP(bf16, O_KVLAT) + (size_t)mm * KVL + (n - 256);
    else if (n < 416) { const int pos = row_pos(mm), c = n - 384; bf16* kr = WSP(bf16, O_KR);
      if (mm < RX) dst = kr + ((size_t)(mm >> 14) * NKEY + KPAD + pos) * 32 + c;
      else { *(u32x4*)(kr + ((size_t)NKEY + KPAD + pos) * 32 + c) = v; dst = kr + ((size_t)KPAD + pos) * 32 + c; } }
    else if (n < 928) { if (mm >= RX) continue; dst = WSP(bf16, O_AGATE) + (size_t)mm * DA + (n - 416); }
    else if (n < 1440) { const int c = n - 928; dst = WSP(bf16, O_SUG) + ((size_t)(c >> 4) * RP + mm) * GH + (c & 15); }
    else { if (mm >= RX) continue; dst = WSP(bf16, O_SGATE) + (size_t)mm * DS + (n - 1440); }
    *(u32x4*)dst = v;
  }
}
__device__ __forceinline__ void phase_inproj(const P& p, int tile, char* lds) {
  const int rnd = tile >> 8, s = tile & 255, xcd = s & 7, slot = s >> 3;
  const int mt = rnd * 32 + xcd * 4 + (slot >> 3), nt = slot & 7;
  if (mt > 128) return;
  const int m0 = mt * 256, n0 = nt * 256;
  f32x16 acc[4][2]; ALBn al{WSP(bf16, O_XB), LDK, RT - 1};
  gemm_main<256, 256, 64, 2, 4, -1>(lds, al, m0, WSP(bf16, O_WTIN), LDK, n0, DIN - 1, DM, acc);
  const int tid_ = otid(), lane = tid_ & 63, wid = tid_ >> 6, wm = wid >> 2, wn = wid & 3, r32 = lane & 31, hi = lane >> 5;
  const int mw = m0 + wm * 128, nb = n0 + wn * 64; char* wl = lds + wid * (32 * EP_RS);
  inproj_rows(p, wl, acc[0][0], acc[0][1], mw, nb, lane, r32, hi);
  inproj_rows(p, wl, acc[1][0], acc[1][1], mw + 32, nb, lane, r32, hi);
  inproj_rows(p, wl, acc[2][0], acc[2][1], mw + 64, nb, lane, r32, hi);
  inproj_rows(p, wl, acc[3][0], acc[3][1], mw + 96, nb, lane, r32, hi);
  __syncthreads();
}
constexpr int NT_QUP = (RX / 256) * 3, NT_KVUP = (RP / 256) * 4;
__device__ __forceinline__ void qup_epi(const P& p, f32x16 a, int m, int nb, int hi, float rs) {
  const int h = nb / DQK, c0 = nb % DQK, b = m >> 14, ii = m & (SEQ - 1);
#pragma unroll
  for (int r = 0; r < 16; ++r) a[r] *= rs;
  if (c0 == 64) rope_block(a, WSP(float2, O_ROPE) + (ii + NMETA) * 16, hi);
  bf16* dst = WSP(bf16, O_Q) + (((size_t)b * NH + h) * SEQ + ii) * DQK + c0 + 4 * hi;
#pragma unroll
  for (int g = 0; g < 4; ++g) *(uint2*)(dst + 8 * g) = pack4(a[4 * g], a[4 * g + 1], a[4 * g + 2], a[4 * g + 3]);
}
__device__ __forceinline__ void phase_qup(const P& p, int tile, char* lds) {
  const int mt = tile / 3, nt = tile % 3, m0 = mt * 256, n0 = nt * 256;
  f32x16 acc[4][2]; ALB al{WSP(bf16, O_QLAT), QL, RT - 1};
  gemm_main<256, 256, 64, 2, 4, -1>(lds, al, m0, WSP(bf16, O_WTQ), QL, n0, 767, QL, acc);
  const int tid_ = otid(), lane = tid_ & 63, wid = tid_ >> 6, wm = wid >> 2, wn = wid & 3, r32 = lane & 31, hi = lane >> 5;
  const float* rowss = (const float*)(lds + LDS_ROWSS); const int lr = wm * 128 + r32, nb = n0 + wn * 64;
  constexpr float QC = 0.10206207261596577f * 1.4426950408889634f;
#define QROW(i) do { const float rs_ = rsqrtf(rowss[lr + 32 * (i)] * (1.f / QL) + EPS) * QC; qup_epi(p, acc[i][0], m0 + lr + 32 * (i), nb, hi, rs_); qup_epi(p, acc[i][1], m0 + lr + 32 * (i), nb + 32, hi, rs_); } while (0)
  QROW(0); QROW(1); QROW(2); QROW(3);
#undef QROW
  __syncthreads();
}
__device__ __forceinline__ void kvup_epi(const P& p, const f32x16& a, int m, int nb, int hi, float rs) {
  if (m >= RT) return;
  const int h = nb >> 7, c0 = nb & 127; bf16* base = c0 < 64 ? WSP(bf16, O_KN) : WSP(bf16, O_V); const int c = (c0 & 63) + 4 * hi;
#pragma unroll
  for (int g = 0; g < 4; ++g) { const uint2 w = pack4(a[4 * g] * rs, a[4 * g + 1] * rs, a[4 * g + 2] * rs, a[4 * g + 3] * rs);
    if (m < RX) *(uint2*)(base + (((size_t)(m >> 14) * NH + h) * NKEY + KPAD + NMETA + (m & (SEQ - 1))) * 64 + c + 8 * g) = w;
    else { const int jk = KPAD + (m - RX); *(uint2*)(base + ((size_t)h * NKEY + jk) * 64 + c + 8 * g) = w; *(uint2*)(base + (((size_t)NH + h) * NKEY + jk) * 64 + c + 8 * g) = w; } }
}
__device__ __forceinline__ void phase_kvup(const P& p, int tile, char* lds) {
  const int mt = tile >> 2, nt = tile & 3, m0 = mt * 256, n0 = nt * 256;
  f32x16 acc[4][2]; ALB al{WSP(bf16, O_KVLAT), KVL, RT - 1};
  gemm_main<256, 256, 64, 2, 4, -1>(lds, al, m0, WSP(bf16, O_WTKV), KVL, n0, 1023, KVL, acc);
  const int tid_ = otid(), lane = tid_ & 63, wid = tid_ >> 6, wm = wid >> 2, wn = wid & 3, r32 = lane & 31, hi = lane >> 5;
  const float* rowss = (const float*)(lds + LDS_ROWSS); const int lr = wm * 128 + r32, nb = n0 + wn * 64;
#define KVROW(i) do { const float rs_ = rsqrtf(rowss[lr + 32 * (i)] * (1.f / KVL) + EPS); kvup_epi(p, acc[i][0], m0 + lr + 32 * (i), nb, hi, rs_); kvup_epi(p, acc[i][1], m0 + lr + 32 * (i), nb + 32, hi, rs_); } while (0)
  KVROW(0); KVROW(1); KVROW(2); KVROW(3);
#undef KVROW
  __syncthreads();
}
__device__ __forceinline__ float pair_sum(float v) { return v + __shfl_xor(v, 32); }
constexpr int NT_GLU = 512;
__device__ __forceinline__ void glu_epi(const P& p, const f32x16& av, const f32x16& ag, int m, int q, int hi) {
  const float* bg = WSP(float, O_BGLU); const bf16* sg = WSP(bf16, O_SGATE); bf16* yrow = WSP(bf16, O_YSN) + (size_t)m * DS + q * 32; float part = 0.f;
#pragma unroll
  for (int g = 0; g < 4; ++g) { const int cc = 8 * g + 4 * hi; const f32x4v ba = *(const f32x4v*)(bg + q * 64 + cc), bgt = *(const f32x4v*)(bg + q * 64 + 32 + cc);
    const uint2 gw = *(const uint2*)(sg + (size_t)m * DS + q * 32 + cc); const float gt[4] = {bflo(gw.x), bfhi(gw.x), bflo(gw.y), bfhi(gw.y)}; float v[4];
#pragma unroll
    for (int e = 0; e < 4; ++e) { const float a_ = av[4 * g + e] + ba[e], g_ = ag[4 * g + e] + bgt[e]; v[e] = a_ / (1.f + __expf(-g_)) * gt[e]; part += v[e] * v[e]; }
    *(uint2*)(yrow + cc) = pack4(v[0], v[1], v[2], v[3]); }
  part = pair_sum(part);
  if (hi == 0) WSP(float, O_GPART)[(size_t)q * RX + m] = part;
}
__device__ __forceinline__ void phase_glu(const P& p, int tile, char* lds) {
  const int rnd = tile >> 8, s = tile & 255, xcd = s & 7, slot = s >> 3, mt = rnd * 64 + xcd * 8 + (slot >> 2), nt = slot & 3, m0 = mt * 256;
  f32x16 acc[4][2]; ALBn al{WSP(bf16, O_YSG), DS, RX - 1};
  gemm_main<256, 256, 64, 2, 4, -1>(lds, al, m0, WSP(bf16, O_WTGLU), DS, nt * 256, 1023, DS, acc);
  const int tid_ = otid(), lane = tid_ & 63, wid = tid_ >> 6, wm = wid >> 2, wn = wid & 3, r32 = lane & 31, hi = lane >> 5;
  const int m = m0 + wm * 128 + r32, q = nt * 4 + wn;
  glu_epi(p, acc[0][0], acc[0][1], m, q, hi); glu_epi(p, acc[1][0], acc[1][1], m + 32, q, hi);
  glu_epi(p, acc[2][0], acc[2][1], m + 64, q, hi); glu_epi(p, acc[3][0], acc[3][1], m + 96, q, hi);
  __syncthreads();
}
constexpr int NT_OUT = 512;
__device__ __forceinline__ float out_epi(const P& p, const f32x16& a, int m, int nb, int hi, float sc) {
  bf16* yrow = WSP(bf16, O_Y) + (size_t)m * DM + nb + 4 * hi; float part = 0.f;
#pragma unroll
  for (int g = 0; g < 4; ++g) { const float v0 = a[4 * g] * sc, v1 = a[4 * g + 1] * sc, v2 = a[4 * g + 2] * sc, v3 = a[4 * g + 3] * sc;
    part += v0 * v0 + v1 * v1 + v2 * v2 + v3 * v3; *(uint2*)(yrow + 8 * g) = pack4(v0, v1, v2, v3); }
  return part;
}
__device__ __forceinline__ void phase_out(const P& p, int tile, char* lds) {
  const int rnd = tile >> 8, s = tile & 255, xcd = s & 7, slot = s >> 3, mt = rnd * 64 + xcd * 8 + (slot >> 2), nt = slot & 3, m0 = mt * 256;
  float* isc = (float*)(lds + LDS_RED);
  { const int t = otid(); if (t < 256) { const float* gp = WSP(float, O_GPART) + m0 + t; float sq = 0.f;
#pragma unroll
      for (int q = 0; q < 16; ++q) sq += gp[(size_t)q * RX];
      isc[t] = sqrtf(sq * (1.f / DS) + EPS); } }
  __syncthreads();
  f32x16 acc[4][2]; ALOut al{WSP(bf16, O_YA), WSP(bf16, O_YSN)};
  gemm_main<256, 256, 64, 2, 4, 8>(lds, al, m0, WSP(bf16, O_WTOUT), DM, nt * 256, 1023, DM, acc, isc);
  const int tid_ = otid(), lane = tid_ & 63, wid = tid_ >> 6, wm = wid >> 2, wn = wid & 3, r32 = lane & 31, hi = lane >> 5;
  const int lr = wm * 128 + r32, m = m0 + lr, nb = nt * 256 + wn * 64; float* yp = WSP(float, O_YPART) + (size_t)(nt * 4 + wn) * RX;
#define OUT_ROW(i) do { const float sc_ = 1.f / isc[lr + 32 * (i)]; float part_ = out_epi(p, acc[i][0], m + 32 * (i), nb, hi, sc_) + out_epi(p, acc[i][1], m + 32 * (i), nb + 32, hi, sc_); \
    part_ = pair_sum(part_); if (hi == 0) yp[m + 32 * (i)] = part_; } while (0)
  OUT_ROW(0); OUT_ROW(1); OUT_ROW(2); OUT_ROW(3);
#undef OUT_ROW
  __syncthreads();
}
__device__ __forceinline__ void phase_final(const P& p) {
  const int t = threadIdx.x, rsub = t >> 7, c = (t & 127) * 8; const float* yp = WSP(float, O_YPART);
  const f32x4v w0 = *(const f32x4v*)(p.post_w + c), w1 = *(const f32x4v*)(p.post_w + c + 4);
  for (int row = blockIdx.x * 4 + rsub; row < RX; row += gridDim.x * 4) {
    float sq = 0.f;
#pragma unroll
    for (int q = 0; q < 16; ++q) sq += yp[(size_t)q * RX + row];
    const float rs = rsqrtf(sq * (1.f / DM) + EPS);
    const u32x4 yv = *(const u32x4*)(WSP(bf16, O_Y) + (size_t)row * DM + c);
    const f32x4v x0 = *(const f32x4v*)(p.x + (size_t)row * DM + c), x1 = *(const f32x4v*)(p.x + (size_t)row * DM + c + 4);
    f32x4v o0, o1;
    o0[0] = x0[0] + bflo(yv[0]) * rs * w0[0]; o0[1] = x0[1] + bfhi(yv[0]) * rs * w0[1]; o0[2] = x0[2] + bflo(yv[1]) * rs * w0[2]; o0[3] = x0[3] + bfhi(yv[1]) * rs * w0[3];
    o1[0] = x1[0] + bflo(yv[2]) * rs * w1[0]; o1[1] = x1[1] + bfhi(yv[2]) * rs * w1[1]; o1[2] = x1[2] + bflo(yv[3]) * rs * w1[2]; o1[3] = x1[3] + bfhi(yv[3]) * rs * w1[3];
    *(f32x4v*)(p.out + (size_t)row * DM + c) = o0; *(f32x4v*)(p.out + (size_t)row * DM + c + 4) = o1;
  }
}

using s16x4 = __attribute__((ext_vector_type(4))) short;
constexpr float ATT_SCALE = 0.10206207261596577f;
constexpr float ATT_THR = 8.f;
constexpr int A_SHM_V = 8192, A_SHM_KN = 8192, A_SHM_KR = 4096;
constexpr int A_OFF_V = 0, A_OFF_KN = 2 * A_SHM_V, A_OFF_KR = A_OFF_KN + 2 * A_SHM_KN, A_OFF_WS = A_OFF_KR + 2 * A_SHM_KR;
#define SBAR() __builtin_amdgcn_sched_barrier(0)
__device__ __forceinline__ unsigned cvtpkv(float lo, float hi) { unsigned r; asm volatile("v_cvt_pk_bf16_f32 %0, %1, %2" : "=v"(r) : "v"(lo), "v"(hi)); return r; }
constexpr float ATT_THR2 = 60.f;
__device__ __forceinline__ float rowmaxSM(const f32x16& p0, const f32x16& p1) {
  float pmax = p0[0];
#pragma unroll
  for (int r = 1; r < 16; ++r) pmax = fmaxf(pmax, p0[r]);
#pragma unroll
  for (int r = 0; r < 16; ++r) pmax = fmaxf(pmax, p1[r]);
  auto rr = __builtin_amdgcn_permlane32_swap(__float_as_uint(pmax), __float_as_uint(pmax), false, false);
  return fmaxf(__uint_as_float(rr[0]), __uint_as_float(rr[1]));
}
__device__ __forceinline__ void decideSM(f32x16& p0, f32x16& p1, float pmax, float& m_reg, float& alpha, bool& zref) {
  if (__builtin_expect(__all(pmax <= ATT_THR2), 1)) { alpha = 1.f; }
  else { const float delta = fmaxf(pmax, 0.f); alpha = __builtin_amdgcn_exp2f(-delta); m_reg += delta; zref = false;
#pragma unroll
    for (int r = 0; r < 16; ++r) { p0[r] -= delta; p1[r] -= delta; } }
#pragma unroll
  for (int r = 0; r < 16; ++r) p0[r] = __builtin_amdgcn_exp2f(p0[r]);
}
__device__ __forceinline__ void firstSM(f32x16& p0, f32x16& p1, float pmax, float& m_reg, float& alpha, bool& zref) {
  alpha = 1.f;
  if (!__all(fabsf(pmax) <= ATT_THR2)) { const float delta = fabsf(pmax) <= ATT_THR2 ? 0.f : pmax; m_reg = delta; zref = false;
#pragma unroll
    for (int r = 0; r < 16; ++r) { p0[r] -= delta; p1[r] -= delta; } }
#pragma unroll
  for (int r = 0; r < 16; ++r) p0[r] = __builtin_amdgcn_exp2f(p0[r]);
}
#define SCHEDPAT() do { _Pragma("unroll") for (int i_ = 0; i_ < 20; ++i_) { __builtin_amdgcn_sched_group_barrier(0x008, 1, 0); __builtin_amdgcn_sched_group_barrier(0x100, 2, 0); __builtin_amdgcn_sched_group_barrier(0x002, 4, 0); } } while (0)
__device__ __forceinline__ void finishSM(f32x16& p0, f32x16& p1, float alpha, float& l_reg, bf16x8& pa0, bf16x8& pa1, bf16x8& pa2, bf16x8& pa3) {
#pragma unroll
  for (int r = 0; r < 16; ++r) p1[r] = __builtin_amdgcn_exp2f(p1[r]);
  float ps = 0;
#pragma unroll
  for (int r = 0; r < 16; ++r) ps += p0[r];
#pragma unroll
  for (int r = 0; r < 16; ++r) ps += p1[r];
  { auto rr = __builtin_amdgcn_permlane32_swap(__float_as_uint(ps), __float_as_uint(ps), false, false);
    ps = __uint_as_float(rr[0]) + __uint_as_float(rr[1]); }
  l_reg = l_reg * alpha + ps;
#define PK4(Pv, BASE, OUT) do { u32x4 w = {cvtpkv(Pv[BASE + 0], Pv[BASE + 1]), cvtpkv(Pv[BASE + 2], Pv[BASE + 3]), cvtpkv(Pv[BASE + 4], Pv[BASE + 5]), cvtpkv(Pv[BASE + 6], Pv[BASE + 7])}; \
    OUT = (bf16x8)w; } while (0)
  PK4(p0, 0, pa0); PK4(p0, 8, pa1); PK4(p1, 0, pa2); PK4(p1, 8, pa3);
#undef PK4
}
__device__ __forceinline__ void qkt(f32x16& p0, f32x16& p1, const char* Kn, const char* Kr, const bf16x8* qr, int r32, int hi, float init) {
#pragma unroll
  for (int r = 0; r < 16; ++r) { p0[r] = init; p1[r] = init; }
#pragma unroll
  for (int d0 = 0; d0 < 4; ++d0) {
    bf16x8 b0 = *(const bf16x8*)(Kn + swz<128>(r32, d0 * 2 + hi));
    bf16x8 b1 = *(const bf16x8*)(Kn + swz<128>(32 + r32, d0 * 2 + hi));
    p0 = __builtin_amdgcn_mfma_f32_32x32x16_bf16(b0, qr[d0], p0, 0, 0, 0);
    p1 = __builtin_amdgcn_mfma_f32_32x32x16_bf16(b1, qr[d0], p1, 0, 0, 0); }
#pragma unroll
  for (int d0 = 0; d0 < 2; ++d0) {
    bf16x8 b0 = *(const bf16x8*)(Kr + swz<64>(r32, d0 * 2 + hi));
    bf16x8 b1 = *(const bf16x8*)(Kr + swz<64>(32 + r32, d0 * 2 + hi));
    p0 = __builtin_amdgcn_mfma_f32_32x32x16_bf16(b0, qr[4 + d0], p0, 0, 0, 0);
    p1 = __builtin_amdgcn_mfma_f32_32x32x16_bf16(b1, qr[4 + d0], p1, 0, 0, 0); }
}
__device__ __forceinline__ int v_st(int k, int c) { const int kk = k;     return ((kk >> 3) * 2 + (c >> 5)) * 512 + ((kk & 7) * 32 + (c & 31)) * 2; }
__device__ __forceinline__ int v_rd_base(int lane) { return ((lane & 3) << 3) | (((lane >> 2) & 3) << 6) | (((lane >> 4) & 1) << 5) | (((lane >> 5) & 1) << 8); }
constexpr int v_rd_off(int d0, int ks, int half) { return d0 * 512 + ks * 2048 + half * 1024; }
template <int OFF> __device__ __forceinline__ s16x4 tr_read(int vb) {
  return __builtin_amdgcn_ds_read_tr16_b64_v4i16((__attribute__((address_space(3))) s16x4*)(uintptr_t)(unsigned)(vb + OFF));
}
template <int D0> __device__ __forceinline__ void pv_one(f32x16& od, int vb, bf16x8 pa0, bf16x8 pa1, bf16x8 pa2, bf16x8 pa3) {
  const s16x4 l0 = tr_read<v_rd_off(D0, 0, 0)>(vb), h0 = tr_read<v_rd_off(D0, 0, 1)>(vb), l1 = tr_read<v_rd_off(D0, 1, 0)>(vb), h1 = tr_read<v_rd_off(D0, 1, 1)>(vb);
  const s16x4 l2 = tr_read<v_rd_off(D0, 2, 0)>(vb), h2 = tr_read<v_rd_off(D0, 2, 1)>(vb), l3 = tr_read<v_rd_off(D0, 3, 0)>(vb), h3 = tr_read<v_rd_off(D0, 3, 1)>(vb);
#define PKV(L, H) (bf16x8){L[0], L[1], L[2], L[3], H[0], H[1], H[2], H[3]}
  od = __builtin_amdgcn_mfma_f32_32x32x16_bf16(PKV(l0, h0), pa0, od, 0, 0, 0);
  od = __builtin_amdgcn_mfma_f32_32x32x16_bf16(PKV(l1, h1), pa1, od, 0, 0, 0);
  od = __builtin_amdgcn_mfma_f32_32x32x16_bf16(PKV(l2, h2), pa2, od, 0, 0, 0);
  od = __builtin_amdgcn_mfma_f32_32x32x16_bf16(PKV(l3, h3), pa3, od, 0, 0, 0);
#undef PKV
}
constexpr int NT_ATTN = NB * NH * (SEQ / 256);
constexpr int ATT_NT = NKEY / 64;
#ifndef ATT_FORCE_FALLBACK
#define ATT_FORCE_FALLBACK 0
#endif
template <bool FAST> __device__ __forceinline__ void attn_item(const P& p, int item, char* lds) {
  const int rnd = item >> 8, s = item & 255, xcd = s & 7, idx = s >> 3;
  const int bh = rnd * 4 + (xcd >> 1), qblk = (xcd & 1) * 32 + idx, b = bh >> 3, h = bh & 7, i0 = qblk * 256;
  const int tid = otid(), wid = tid >> 6, lane = tid & 63, r32 = lane & 31, hi = lane >> 5;
  const bf16* Qb = WSP(bf16, O_Q) + ((size_t)bh * SEQ + i0) * DQK;
  const bf16* Knh = WSP(bf16, O_KN) + (size_t)bh * NKEY * 64; const bf16* Vh = WSP(bf16, O_V) + (size_t)bh * NKEY * 64;
  const bf16* Krb = WSP(bf16, O_KR) + (size_t)b * NKEY * 32;
  char* V_lds = lds + A_OFF_V; char* Kn_lds = lds + A_OFF_KN; char* Kr_lds = lds + A_OFF_KR;
  volatile unsigned* redo = (volatile unsigned*)(lds + A_OFF_WS);
  if (FAST && tid == 0) *redo = 0u;
  float m_reg = 0.f, l_reg = 0; bool zref = true; f32x16 o[2]; bf16x8 qr[6];
#pragma unroll
  for (int r = 0; r < 16; ++r) { o[0][r] = 0.f; o[1][r] = 0.f; }
  const bf16* Qw = Qb + (size_t)(wid * 32 + r32) * DQK + hi * 8;
#pragma unroll
  for (int d0 = 0; d0 < 6; ++d0) qr[d0] = *(const bf16x8*)(Qw + d0 * 16);
  const int sr = tid >> 3, sc = tid & 7;
  const int vst = v_st(sr, sc * 8), knst = swz<128>(sr, sc), krst = swz<64>(sr, sc >> 1) + (sc & 1) * 8;
  const int vb0 = (int)(uintptr_t)V_lds + v_rd_base(lane);
  struct { u32x4 v, kn; uint2 kr; } st_[2];
#define SLOAD(i, k0) do { st_[i].v = *(const u32x4*)(Vh + (size_t)((k0) + sr) * 64 + sc * 8); st_[i].kn = *(const u32x4*)(Knh + (size_t)((k0) + sr) * 64 + sc * 8); \
    st_[i].kr = *(const uint2*)(Krb + (size_t)((k0) + sr) * 32 + sc * 4); } while (0)
#define SWRITE(bq, i) do { *(u32x4*)(V_lds + (bq) * A_SHM_V + vst) = st_[i].v; *(u32x4*)(Kn_lds + (bq) * A_SHM_KN + knst) = st_[i].kn; \
    *(uint2*)(Kr_lds + (bq) * A_SHM_KR + krst) = st_[i].kr; } while (0)
#define SWAIT() asm volatile("s_waitcnt vmcnt(3)" ::: "memory")
#define RESC(a) do { if (__any((a) < 1.f)) { _Pragma("unroll") for (int d = 0; d < 2; ++d) _Pragma("unroll") for (int r = 0; r < 16; ++r) o[d][r] *= (a); } } while (0)
#define PV(vbx) do { pv_one<0>(o[0], (vbx), pa0, pa1, pa2, pa3); pv_one<1>(o[1], (vbx), pa0, pa1, pa2, pa3); } while (0)
  f32x16 pA0, pA1, pB0, pB1; float alA, alB; bf16x8 pa0, pa1, pa2, pa3; constexpr int NT = ATT_NT;
  constexpr int SE = 0, SO = 1;
  if (wid >= 4) __builtin_amdgcn_s_setprio(1);
  SLOAD(SE, 0); asm volatile("s_waitcnt vmcnt(0)" ::: "memory"); SWRITE(0, SE); __syncthreads();
  qkt(pA0, pA1, Kn_lds, Kr_lds, qr, r32, hi, 0.f);
#pragma unroll
  for (int r = 0; r < 16; ++r) pA0[r] = -1e30f;
#pragma unroll
  for (int r = 0; r < 8; ++r) pA1[r] = -1e30f;
  { const float pm_ = rowmaxSM(pA0, pA1); firstSM(pA0, pA1, pm_, m_reg, alA, zref); }
  bool bad = FAST && !zref;
  SLOAD(SO, 64); SLOAD(SE, 128);
  SWAIT(); SWRITE(1, SO); __syncthreads();
  for (int j = 1; j + 1 < NT; j += 2) {
    if (FAST || zref) qkt(pB0, pB1, Kn_lds + A_SHM_KN, Kr_lds + A_SHM_KR, qr, r32, hi, 0.f); else qkt(pB0, pB1, Kn_lds + A_SHM_KN, Kr_lds + A_SHM_KR, qr, r32, hi, -m_reg);
    finishSM(pA0, pA1, alA, l_reg, pa0, pa1, pa2, pa3);
    SLOAD(SO, (j + 2 < NT ? j + 2 : NT - 1) * 64);
    PV(vb0);
    if (FAST) { SCHEDPAT(); alB = 1.f; _Pragma("unroll") for (int r = 0; r < 16; ++r) pB0[r] = __builtin_amdgcn_exp2f(pB0[r]); }
    else { const float pm_ = rowmaxSM(pB0, pB1); SCHEDPAT(); decideSM(pB0, pB1, pm_, m_reg, alB, zref); }
    __syncthreads(); SWAIT(); SWRITE(0, SE);
    if (!FAST) RESC(alB);
    __syncthreads();
    if (FAST || zref) qkt(pA0, pA1, Kn_lds, Kr_lds, qr, r32, hi, 0.f); else qkt(pA0, pA1, Kn_lds, Kr_lds, qr, r32, hi, -m_reg);
    finishSM(pB0, pB1, alB, l_reg, pa0, pa1, pa2, pa3);
    SLOAD(SE, (j + 3 < NT ? j + 3 : NT - 1) * 64);
    PV(vb0 + A_SHM_V);
    if (FAST) { SCHEDPAT(); alA = 1.f; _Pragma("unroll") for (int r = 0; r < 16; ++r) pA0[r] = __builtin_amdgcn_exp2f(pA0[r]); }
    else { const float pm_ = rowmaxSM(pA0, pA1); SCHEDPAT(); decideSM(pA0, pA1, pm_, m_reg, alA, zref); }
    __syncthreads(); SWAIT(); SWRITE(1, SO);
    if (!FAST) RESC(alA);
    __syncthreads();
  }
  __builtin_amdgcn_s_setprio(0);
  finishSM(pA0, pA1, alA, l_reg, pa0, pa1, pa2, pa3); SBAR();
  PV(vb0);
  if (FAST) { float chk = l_reg;
#pragma unroll
    for (int r = 0; r < 16; ++r) chk += fabsf(o[0][r]) + fabsf(o[1][r]);
    bad = bad || !(chk < 3.0e38f) || !(l_reg > 0.f) ; if (ATT_FORCE_FALLBACK) { int one_ = 1; asm volatile("" : "+v"(one_)); bad = bad || (one_ != 0); }
    if (__any(bad) && lane == 0) *redo = 1u; }
  { const float rl = __builtin_amdgcn_rcpf(l_reg); const size_t rowoff = (size_t)(b * SEQ + i0 + wid * 32 + r32) * DA + h * 64 + 4 * hi;
    const bf16* gate = WSP(bf16, O_AGATE) + rowoff; bf16* ya = WSP(bf16, O_YA) + rowoff;
#pragma unroll
    for (int d0 = 0; d0 < 2; ++d0)
#pragma unroll
      for (int g = 0; g < 4; ++g) { const uint2 gw = *(const uint2*)(gate + d0 * 32 + 8 * g);
        *(uint2*)(ya + d0 * 32 + 8 * g) = pack4(o[d0][4 * g] * rl * bflo(gw.x), o[d0][4 * g + 1] * rl * bfhi(gw.x), o[d0][4 * g + 2] * rl * bflo(gw.y), o[d0][4 * g + 3] * rl * bfhi(gw.y)); } }
  __syncthreads();
  bool again = false; if (FAST) { again = (*redo != 0u); __syncthreads(); }
#undef SLOAD
#undef SWRITE
#undef SWAIT
#undef RESC
#undef PV
  if (FAST) { if (again) attn_item<false>(p, item, lds); }
}


__device__ __forceinline__ void build_tables_p1(const P& p) {
  const size_t gid = blockIdx.x * 512ull + threadIdx.x, gsz = gridDim.x * 512ull;
  const float2* pw = WSP(float2, O_PW); const float2* bbar = WSP(float2, O_BBAR); float* Kt = WSP(float, O_KT); bf16* WS = WSP(bf16, O_WS);
  for (size_t i = gid; i < (size_t)2 * 32 * 16 * 256; i += gsz) { const int h = i & 15, hp = (i >> 4) & 15, d = (i >> 8) & 15, dg = i >> 12;
    float s = 0.f;
#pragma unroll 8
    for (int pp = 0; pp < 64; ++pp) { const float2 pv = pw[(dg * 64 + pp) * 17 + d]; const float cr = p.c_re[(dg * 16 + hp) * 64 + pp], ci = p.c_im[(dg * 16 + hp) * 64 + pp];
      const float2 bb = bbar[(dg * 64 + pp) * 16 + h]; const float xr = cr * pv.x - ci * pv.y, xi = cr * pv.y + ci * pv.x; s += xr * bb.x - xi * bb.y; }
    Kt[i] = s; }
  for (size_t i8 = gid; i8 < (size_t)32 * 256 * 256 / 8; i8 += gsz) { const size_t i = i8 * 8; const int k = i & 255, n = (i >> 8) & 255, g = i >> 16; const int s = k >> 4, h = k & 15, dirS = n >> 7, pp = (n >> 1) & 63, ri = n & 1;
    const int dg = dirS * 32 + g, e = dirS ? s : 15 - s; const float2 pv = pw[(dg * 64 + pp) * 17 + e]; const float2* bb = bbar + (dg * 64 + pp) * 16 + h; float v[8];
#pragma unroll
    for (int q = 0; q < 8; ++q) { const float2 b_ = bb[q]; v[q] = ri ? (pv.x * b_.y + pv.y * b_.x) : (pv.x * b_.x - pv.y * b_.y); }
    u32x4 w = {cvtpk(v[0], v[1]), cvtpk(v[2], v[3]), cvtpk(v[4], v[5]), cvtpk(v[6], v[7])}; *(u32x4*)(WS + i) = w; }
}
__device__ __forceinline__ void build_tables_p2(const P& p) {
  const size_t gid = blockIdx.x * 512ull + threadIdx.x, gsz = gridDim.x * 512ull;
  const float2* pw = WSP(float2, O_PW); const float* Kt = WSP(float, O_KT); bf16* Msg = WSP(bf16, O_MSG);
  for (size_t i8 = gid; i8 < (size_t)32 * 256 * 512 / 8; i8 += gsz) { const size_t i = i8 * 8; const int k = i & 511, n = (i >> 9) & 255, g = i >> 17; const int t = n >> 4, hp = n & 15; float v[8];
    if (k < 256) { const int s = k >> 4, h = k & 15, o = hp * 16 + h;
      if (s != t) { const float* kt = (s < t) ? Kt + ((size_t)g * 16 + (t - s)) * 256 + o : Kt + ((size_t)(32 + g) * 16 + (s - t)) * 256 + o;
        const f32x4v a = *(const f32x4v*)kt, b = *(const f32x4v*)(kt + 4);
        v[0] = a[0]; v[1] = a[1]; v[2] = a[2]; v[3] = a[3]; v[4] = b[0]; v[5] = b[1]; v[6] = b[2]; v[7] = b[3]; }
      else { const float* k0 = Kt + ((size_t)g * 16) * 256 + o; const float* k1 = Kt + ((size_t)(32 + g) * 16) * 256 + o;
        const f32x4v a = *(const f32x4v*)k0, b = *(const f32x4v*)(k0 + 4), c = *(const f32x4v*)k1, d = *(const f32x4v*)(k1 + 4);
        v[0] = a[0] + c[0]; v[1] = a[1] + c[1]; v[2] = a[2] + c[2]; v[3] = a[3] + c[3]; v[4] = b[0] + d[0]; v[5] = b[1] + d[1]; v[6] = b[2] + d[2]; v[7] = b[3] + d[3]; }
    } else { const int kk = k - 256, dirX = kk >> 7, pp0 = (kk >> 1) & 63, dg = dirX * 32 + g, e = dirX ? 16 - t : t + 1;
#pragma unroll
      for (int q = 0; q < 4; ++q) { const int pp = pp0 + q; const float2 pv = pw[(dg * 64 + pp) * 17 + e]; const float cr = p.c_re[(dg * 16 + hp) * 64 + pp], ci = p.c_im[(dg * 16 + hp) * 64 + pp];
        v[2 * q] = cr * pv.x - ci * pv.y; v[2 * q + 1] = -(cr * pv.y + ci * pv.x); } }
    u32x4 w = {cvtpk(v[0], v[1]), cvtpk(v[2], v[3]), cvtpk(v[4], v[5]), cvtpk(v[6], v[7])}; *(u32x4*)(Msg + i) = w; }
}
constexpr int NT_SSMS = 256, NT_SSMY = 512;
__device__ __forceinline__ void phase_ssmS(const P& p, int tile, char* lds) {
  const int g = tile >> 3, mt = tile & 7, m0 = mt * 256;
  f32x16 acc[4][2]; ALBn al{WSP(bf16, O_SUG) + (size_t)g * RP * GH, 256, 2047};
  gemm_main<256, 256, 64, 2, 4, -1>(lds, al, m0, WSP(bf16, O_WS) + (size_t)g * 65536, 256, 0, 255, 256, acc);
  const int tid_ = otid(), lane = tid_ & 63, wid = tid_ >> 6, wm = wid >> 2, wn = wid & 3, r32 = lane & 31, hi = lane >> 5;
  float* S = WSP(float, O_S) + (size_t)g * 2048 * 256;
#pragma unroll
  for (int i = 0; i < 4; ++i)
#pragma unroll
    for (int j = 0; j < 2; ++j)
#pragma unroll
      for (int q = 0; q < 4; ++q) { f32x4v t4 = {acc[i][j][4 * q], acc[i][j][4 * q + 1], acc[i][j][4 * q + 2], acc[i][j][4 * q + 3]};
        *(f32x4v*)(S + (size_t)(m0 + wm * 128 + i * 32 + r32) * 256 + wn * 64 + j * 32 + 8 * q + 4 * hi) = t4; }
  __syncthreads();
}
struct ALU3 { const bf16* u; const bf16* xa; using Raw = u32x4;
  __device__ __forceinline__ Raw load(int m, int k) const { return *(const u32x4*)(k < 256 ? u + (size_t)m * 256 + k : xa + (size_t)m * 256 + (k - 256)); }
  __device__ __forceinline__ bf16x8 cvt(const Raw& v, int k, float& ss) const { return (bf16x8)v; } };
__device__ __forceinline__ void phase_ssmY(const P& p, int tile, char* lds) {
  const int g = tile >> 4, mt = (tile >> 1) & 7, nt = tile & 1, m0 = mt * 256, n0 = nt * 128;
  const bf16* ug = WSP(bf16, O_SUG) + (size_t)g * RP * GH;
  f32x16 acc[2][2]; ALU3 al{ug, WSP(bf16, O_XA) + (size_t)g * 2048 * 256};
  gemm_main<256, 128, 64, 4, 2, -1>(lds, al, m0, WSP(bf16, O_MSG) + (size_t)g * 256 * 512, 512, n0, 255, 512, acc);
  const int tid_ = otid(), lane = tid_ & 63, wid = tid_ >> 6, wm = wid >> 1, wn = wid & 1, r32 = lane & 31, hi = lane >> 5;
  bf16* ysg = WSP(bf16, O_YSG);
#pragma unroll
  for (int i = 0; i < 2; ++i)
#pragma unroll
    for (int j = 0; j < 2; ++j) { const int m = m0 + wm * 64 + i * 32 + r32;
#pragma unroll
      for (int q = 0; q < 4; ++q) { const int n = n0 + wn * 64 + j * 32 + 8 * q + 4 * hi, t = n >> 4, hp = n & 15;
        const f32x4v dd = *(const f32x4v*)(p.ssm_d + g * 16 + hp); const uint2 uw = *(const uint2*)(ug + (size_t)m * 256 + n);
        const float y0 = acc[i][j][4 * q] + dd[0] * bflo(uw.x), y1 = acc[i][j][4 * q + 1] + dd[1] * bfhi(uw.x), y2 = acc[i][j][4 * q + 2] + dd[2] * bflo(uw.y), y3 = acc[i][j][4 * q + 3] + dd[3] * bfhi(uw.y);
        *(uint2*)(ysg + ((size_t)m * 16 + t) * DS + g * 16 + hp) = pack4(gelu_tanh(y0), gelu_tanh(y1), gelu_tanh(y2), gelu_tanh(y3)); } }
  __syncthreads();
}
__device__ __forceinline__ float2 cmul(float2 a, float2 b) { return make_float2(a.x * b.x - a.y * b.y, a.x * b.y + a.y * b.x); }
__device__ __forceinline__ float2 cfma(float2 a, float2 x, float2 s) { return make_float2(a.x * x.x - a.y * x.y + s.x, a.x * x.y + a.y * x.x + s.y); }
__device__ __forceinline__ void phase_carry1(const P& p) {
  const int nthr = 2 * 32 * 2 * 32 * 64; const float2* pw = WSP(float2, O_PW); float2* E = WSP(float2, O_E);
  for (int idx = blockIdx.x * 512 + threadIdx.x; idx < nthr; idx += gridDim.x * 512) {
    const int pp = idx & 63, sc = (idx >> 6) & 31, dir = (idx >> 11) & 1, g = (idx >> 12) & 31, b = idx >> 17;
    const float2 a16 = pw[((dir * 32 + g) * 64 + pp) * 17 + 16];
    const float* S = WSP(float, O_S) + ((size_t)g * 2048 + b * 1024) * 256 + dir * 128 + pp * 2; float2 X = make_float2(0.f, 0.f);
    for (int q = 0; q < 32; ++q) { const int c = sc * 32 + (dir ? 31 - q : q); const float2 s = *(const float2*)(S + (size_t)c * 256); X = cfma(a16, X, s); }
    E[idx] = X; }
}
__device__ __forceinline__ void phase_carry2(const P& p) {
  const int nthr = 2 * 32 * 2 * 32 * 64; const float2* pw = WSP(float2, O_PW); const float2* E = WSP(float2, O_E); const float2* bbar = WSP(float2, O_BBAR);
  for (int idx = blockIdx.x * 512 + threadIdx.x; idx < nthr; idx += gridDim.x * 512) {
    const int pp = idx & 63, sc = (idx >> 6) & 31, dir = (idx >> 11) & 1, g = (idx >> 12) & 31, b = idx >> 17;
    const int dgp = (dir * 32 + g) * 64 + pp; const float2 a16 = pw[dgp * 17 + 16];
    float2 a512 = a16;
#pragma unroll
    for (int q = 0; q < 5; ++q) a512 = cmul(a512, a512);
    float2 X = make_float2(0.f, 0.f); const float2* Eb = E + (idx & ~(31 << 6) & ~63) + pp;
    if (dir == 0) {
      const bf16* um = WSP(bf16, O_SUG) + ((size_t)g * RP + RX) * GH;
      for (int s = 0; s < 16; ++s) { float2 bu = make_float2(0.f, 0.f);
        for (int h = 0; h < 16; ++h) { const float u = bf2f(um[s * 16 + h]); const float2 bb = bbar[dgp * 16 + h]; bu.x += bb.x * u; bu.y += bb.y * u; }
        X = cfma(pw[dgp * 17 + 1], X, bu); }
      for (int j = 0; j < sc; ++j) X = cfma(a512, X, Eb[j * 64]);
    } else {
      for (int j = 31; j > sc; --j) X = cfma(a512, X, Eb[j * 64]);
    }
    const float* S = WSP(float, O_S) + ((size_t)g * 2048 + b * 1024) * 256 + dir * 128 + pp * 2;
    bf16* XA = WSP(bf16, O_XA) + ((size_t)g * 2048 + b * 1024) * 256 + dir * 128 + pp * 2;
    for (int q = 0; q < 32; ++q) { const int c = sc * 32 + (dir ? 31 - q : q);
      *(unsigned*)(XA + (size_t)c * 256) = cvtpk(X.x, X.y);
      const float2 s = *(const float2*)(S + (size_t)c * 256); X = cfma(a16, X, s); }
  }
}


#define XB_TMO      128
#define XB_XCNT(j)  (256  + 64 * (j))
#define XB_XSUB(j)  (1280 + 64 * (j))
#define XB_XGEN(j)  (2304 + 64 * (j))
#define XB_TOP      3328
#define XB_TOPGEN   3392
#define XCD_BAR_WORDS 3456
#define XB_SPIN_CAP (1u << 22)
#define LAS __attribute__((address_space(3)))
__device__ __forceinline__ unsigned xb_ld(unsigned* p)              { return __hip_atomic_load(p, __ATOMIC_RELAXED, __HIP_MEMORY_SCOPE_AGENT); }
__device__ __forceinline__ unsigned xb_add(unsigned* p, unsigned v) { return __hip_atomic_fetch_add(p, v, __ATOMIC_RELAXED, __HIP_MEMORY_SCOPE_AGENT); }
__device__ __forceinline__ unsigned xb_xcc_id() { return (unsigned)__builtin_amdgcn_s_getreg((3 << 11) | 20) & 0xFu; }
#define XB_SPIN(cond, bar) do { unsigned _sp = 0; while (cond) { __builtin_amdgcn_s_sleep(1); \
    if ((++_sp & 255u) == 0u) { if (xb_ld(&(bar)[XB_TMO])) break; if (_sp > XB_SPIN_CAP) { atomicAdd(&(bar)[XB_TMO], 1u); break; } } } } while (0)
struct XcdBarrier { unsigned* bar; unsigned x; volatile LAS unsigned* st; };
__device__ __forceinline__ XcdBarrier xcd_barrier_post(unsigned* bar, volatile LAS unsigned* st) {
  XcdBarrier b; b.bar = bar; b.x = xb_xcc_id(); b.st = st;
  if (threadIdx.x == 0) (void)xb_add(&bar[XB_XCNT(b.x)], 1u);
  return b;
}
__device__ __forceinline__ void xcd_barrier_complete(unsigned* bar, unsigned x, unsigned& nloc, unsigned& nx) {
  const unsigned G = gridDim.x * gridDim.y * gridDim.z; unsigned sum, cnt, mine, sp = 0u;
  for (;;) {
    sum = 0u; cnt = 0u; mine = 0u;
#pragma unroll
    for (unsigned j = 0; j < 16; ++j) { const unsigned c = xb_ld(&bar[XB_XCNT(j)]); sum += c; cnt += (c > 0u) ? 1u : 0u; mine = (j == x) ? c : mine; }
    if (sum == G) break;
    __builtin_amdgcn_s_sleep(1);
    if ((++sp & 255u) == 0u) { if (xb_ld(&bar[XB_TMO])) break; if (sp > XB_SPIN_CAP) { atomicAdd(&bar[XB_TMO], 1u); break; } }
  }
  nloc = mine > 0u ? mine : 1u; nx = cnt > 0u ? cnt : 1u;
}
__device__ __forceinline__ void xcd_barrier(const XcdBarrier& b) {
  asm volatile("s_waitcnt vmcnt(0)" ::: "memory");
  __syncthreads();
  if (threadIdx.x == 0) {
    unsigned* bar = b.bar;
    __builtin_amdgcn_s_waitcnt(0);
    unsigned nloc = b.st[0], nx = b.st[1];
    if (nloc == 0u) { xcd_barrier_complete(bar, b.x, nloc, nx); b.st[0] = nloc; b.st[1] = nx; }
    const unsigned old = xb_add(&bar[XB_XSUB(b.x)], 1u);
    const unsigned gen = old / nloc;
    if (old + 1u == (gen + 1u) * nloc) {
      __builtin_amdgcn_fence(__ATOMIC_RELEASE, "agent");
      asm volatile("s_waitcnt vmcnt(0)" ::: "memory");
      const unsigned og = xb_add(&bar[XB_TOP], 1u);
      const unsigned tg = og / nx;
      if (og + 1u == (tg + 1u) * nx) xb_add(&bar[XB_TOPGEN], 1u);
      else XB_SPIN(xb_ld(&bar[XB_TOPGEN]) == tg, bar);
      __builtin_amdgcn_fence(__ATOMIC_ACQUIRE, "agent");
      xb_add(&bar[XB_XGEN(b.x)], 1u);
      asm volatile("s_waitcnt vmcnt(0)" ::: "memory");
    } else {
      XB_SPIN(xb_ld(&bar[XB_XGEN(b.x)]) == gen, bar);
      __builtin_amdgcn_fence(__ATOMIC_ACQUIRE, "agent");
      asm volatile("s_waitcnt vmcnt(0)" ::: "memory");
    }
  }
  __syncthreads();
}

__global__ void __launch_bounds__(512) k_mega(P p) {
  __shared__ __attribute__((aligned(16))) char lds[LDS_BYTES];
  cg::grid_group grid = cg::this_grid();
  __shared__ uint4 xb_words;
  if (threadIdx.x == 0) xb_words = make_uint4(0u, 0u, 0u, 0u);
  __syncthreads();
  XcdBarrier xbar = xcd_barrier_post(WSP(unsigned, O_BAR), (volatile LAS unsigned*)&xb_words);
#define GSYNC() do { for (int q_ = 0; q_ < REP_SYNC; ++q_) xcd_barrier(xbar); } while (0)
  prep_all(p, lds);
  grid.sync();
  build_tables_p1(p);
  for (int rep = 0; rep < REP_INPROJ; ++rep) for (int t = blockIdx.x; t < NT_INPROJ; t += gridDim.x) phase_inproj(p, t, lds);
  GSYNC();
  build_tables_p2(p);
  for (int rep = 0; rep < REP_P2; ++rep)
  for (int t = blockIdx.x; t < NT_QUP + NT_KVUP + NT_SSMS; t += gridDim.x) { if (t < NT_QUP) phase_qup(p, t, lds); else if (t < NT_QUP + NT_KVUP) phase_kvup(p, t - NT_QUP, lds); else phase_ssmS(p, t - NT_QUP - NT_KVUP, lds); }
  GSYNC();
  phase_carry1(p);
  GSYNC();
  phase_carry2(p);
  GSYNC();
  for (int rep = 0; rep < REP_ATTN; ++rep)
  for (int t = blockIdx.x; t < NT_ATTN + NT_SSMY; t += gridDim.x) { if (t < NT_ATTN) attn_item<true>(p, t, lds); else phase_ssmY(p, t - NT_ATTN, lds); }
  GSYNC();
  for (int rep = 0; rep < REP_GLU; ++rep) for (int t = blockIdx.x; t < NT_GLU; t += gridDim.x) phase_glu(p, t, lds);
  GSYNC();
  for (int rep = 0; rep < REP_OUT; ++rep) for (int t = blockIdx.x; t < NT_OUT; t += gridDim.x) phase_out(p, t, lds);
  GSYNC();
  for (int rep = 0; rep < REP_FIN; ++rep) phase_final(p);
}

extern "C" void kernel_launch(void* const* d_in, const int* in_sizes, int n_in, void* d_out, int out_size, void* d_ws, size_t ws_size, hipStream_t stream) {
  P p{};
  const float** f = (const float**)&p;
  for (int i = 0; i < 22; ++i) f[i] = (const float*)d_in[i];
  p.out = (float*)d_out; p.ws = (char*)d_ws;
  if (ws_size < O_END) { fprintf(stderr, "ws too small\n"); return; }
  static int grid_blocks = 0;
  if (!grid_blocks) {
    int dev = 0, cus = 0, per_cu = 0; hipGetDevice(&dev);
    hipDeviceGetAttribute(&cus, hipDeviceAttributeMultiprocessorCount, dev);
    hipOccupancyMaxActiveBlocksPerMultiprocessor(&per_cu, k_mega, 512, 0);
    if (per_cu < 1) per_cu = 1;
    grid_blocks = cus * per_cu;
  }
  hipMemsetAsync((char*)d_ws + O_BAR, 0, 4096 * 4, stream);
  void* args[] = {&p};
  hipError_t e = hipLaunchCooperativeKernel((void*)k_mega, dim3(grid_blocks), dim3(512), args, 0, stream);
  if (e != hipSuccess) fprintf(stderr, "cooperative launch failed: %s (grid %d)\n", hipGetErrorString(e), grid_blocks);
}
```

```cpp
#include <hip/hip_runtime.h>
#include <hip/hip_bf16.h>
#include <hip/hip_cooperative_groups.h>
#include <cstdio>
namespace cg = cooperative_groups;
#include <stdint.h>
typedef __hip_bfloat16 bf16;
#ifndef REP_ATTN
#define REP_ATTN 1
#endif
#ifndef REP_INPROJ
#define REP_INPROJ 1
#endif
#ifndef REP_TAIL
#define REP_TAIL 1
#endif
#ifndef REP_P2
#define REP_P2 1
#endif
#ifndef REP_GLU
#define REP_GLU 1
#endif
#ifndef REP_OUT
#define REP_OUT 1
#endif
#ifndef REP_FIN
#define REP_FIN 1
#endif
#ifndef REP_SYNC
#define REP_SYNC 1
#endif

constexpr int DM = 1024, SEQ = 16384, NB = 2, NMETA = 16, LTOT = SEQ + NMETA;
constexpr int DIN = 1952, QL = 256, KVL = 128, QR = 32, DA = 512, DS = 512;
constexpr int NH = 8, DQK = 96, DV = 64, NG = 32, GH = 16, NP = 64;
constexpr int RX = NB * SEQ;
constexpr int RT = RX + NMETA;
constexpr int RP = 33024;
constexpr int KPAD = 48;
constexpr int NKEY = LTOT + KPAD;
constexpr float EPS = 1e-6f;
constexpr int LDK = DM + 64;

constexpr size_t al(size_t x) { return (x + 255) / 256 * 256; }
constexpr size_t O_WTIN = 0;
constexpr size_t O_WTQ = O_WTIN + al((size_t)DIN * LDK * 2);
constexpr size_t O_WTKV = O_WTQ + al((size_t)768 * QL * 2);
constexpr size_t O_WTGLU = O_WTKV + al((size_t)1024 * KVL * 2);
constexpr size_t O_WTOUT = O_WTGLU + al((size_t)1024 * DS * 2);
constexpr size_t O_BGLU = O_WTOUT + al((size_t)DM * DM * 2);
constexpr size_t O_ROPE = O_BGLU + al(1024 * 4);
constexpr size_t O_ABAR = O_ROPE + al((size_t)LTOT * 16 * 8);
constexpr size_t O_BBAR = O_ABAR + al(2 * 32 * 64 * 8);
constexpr size_t O_QLAT = O_BBAR + al(2 * 32 * 64 * 16 * 8);
constexpr size_t O_KVLAT = O_QLAT + al((size_t)RP * QL * 2);
constexpr size_t O_AGATE = O_KVLAT + al((size_t)RP * KVL * 2);
constexpr size_t O_SGATE = O_AGATE + al((size_t)RX * DA * 2);
constexpr size_t O_SUG = O_SGATE + al((size_t)RX * DS * 2);
constexpr size_t O_KN = O_SUG + al((size_t)NG * RP * GH * 2);
constexpr size_t O_V = O_KN + al((size_t)NB * NH * NKEY * 64 * 2);
constexpr size_t O_KR = O_V + al((size_t)NB * NH * NKEY * 64 * 2);
constexpr size_t O_Q = O_KR + al((size_t)NB * NKEY * 32 * 2);
constexpr size_t O_YA = O_Q + al((size_t)NB * NH * SEQ * DQK * 2);
constexpr size_t O_YSG = O_YA + al((size_t)RX * DA * 2);
constexpr size_t O_YSN = O_YSG + al((size_t)RX * DS * 2);
constexpr size_t O_RSX = O_YSN + al((size_t)RX * DS * 2);
constexpr size_t O_RSQ = O_RSX + al(RP * 4);
constexpr size_t O_RSKV = O_RSQ + al(RP * 4);
constexpr size_t O_RSA = O_RSKV + al(RP * 4);
constexpr size_t O_PW = O_RSA + al(RP * 4);
constexpr size_t O_KT = O_PW + al(2 * 32 * 64 * 17 * 8);
constexpr size_t O_WS = O_KT + al(2 * 32 * 16 * 256 * 4);
constexpr size_t O_MSG = O_WS + al((size_t)32 * 256 * 256 * 2);
constexpr size_t O_S = O_MSG + al((size_t)32 * 256 * 512 * 2);
constexpr size_t O_XB = O_S;
constexpr size_t O_E = O_S + al((size_t)RP * LDK * 2);
constexpr size_t O_XA = O_E + al((size_t)2 * 32 * 2 * 32 * 64 * 8);
constexpr size_t O_BAR = O_XA + al((size_t)32 * 2048 * 256 * 2);
constexpr size_t O_GPART = O_BAR + al(4096 * 4);
constexpr size_t O_YPART = O_GPART + al((size_t)16 * RX * 4);
constexpr size_t O_Y = O_S;
constexpr size_t O_END = O_YPART + al((size_t)16 * RX * 4);

struct P {
  const float *x, *meta, *pre_w, *post_w, *w_in, *qn_w, *w_qup, *kvn_w, *w_kvup, *aon_w;
  const float *a_re, *a_im, *log_dt, *b_re, *b_im, *c_re, *c_im, *ssm_d, *w_glu, *b_glu, *son_w, *w_out;
  float* out; char* ws;
};
#define WSP(T, off) ((T*)(p.ws + (off)))

__device__ __forceinline__ float bf2f(bf16 v) { return __bfloat162float(v); }
__device__ __forceinline__ bf16 f2bf(float v) { return __float2bfloat16(v); }
__device__ __forceinline__ float silu(float v) { return v / (1.f + __expf(-v)); }
__device__ __forceinline__ float gelu_tanh(float v) {
  const float u = 0.7978845608028654f * (v + 0.044715f * v * v * v);
  return v / (1.f + __expf(-2.f * u));
}
__device__ __forceinline__ const float* xrow(const P& p, int r) {
  return r < RX ? p.x + (size_t)r * DM : p.meta + (size_t)(r - RX) * DM;
}
__device__ __forceinline__ void sincos_red(double ang, float& c, float& s) {
  const double TWO_PI = 6.283185307179586476925;
  double n = rint(ang / TWO_PI); float r = (float)(ang - n * TWO_PI);
  c = cosf(r); s = sinf(r);
}

using bf16x8 = __attribute__((ext_vector_type(8))) short;
using f32x16 = __attribute__((ext_vector_type(16))) float;
using f32x4v = __attribute__((ext_vector_type(4))) float;
using u32x4 = __attribute__((ext_vector_type(4))) unsigned;
__device__ __forceinline__ int otid() { int t = threadIdx.x; asm volatile("" : "+v"(t)); return t; }
__device__ __forceinline__ int crow(int r, int hi) { return (r & 3) + 8 * (r >> 2) + 4 * hi; }
__device__ __forceinline__ unsigned cvtpk(float lo, float hi) { unsigned r; asm("v_cvt_pk_bf16_f32 %0, %1, %2" : "=v"(r) : "v"(lo), "v"(hi)); return r; }
__device__ __forceinline__ float bflo(unsigned u) { return __uint_as_float(u << 16); }
__device__ __forceinline__ float bfhi(unsigned u) { return __uint_as_float(u & 0xffff0000u); }
__device__ __forceinline__ void stbf(bf16* dst, float v) { *(unsigned short*)dst = (unsigned short)(cvtpk(v, v) & 0xffffu); }

__device__ __forceinline__ void prep_transposes(const P& p, char* lds) {
  float* T = (float*)lds; const int tid = threadIdx.x;
  constexpr int T_IN = 16 * 31, T_OUT = 16 * 16, T_GLU = 8 * 16, T_Q = 4 * 12, T_KV = 2 * 16, T_ALL = T_IN + T_OUT + T_GLU + T_Q + T_KV;
  for (int t = blockIdx.x; t < T_ALL; t += gridDim.x) {
    const float* W; const float* g0; const float* g1 = nullptr; bf16* dst; int N, ldk, kt, nt_, which;
    if (t < T_IN) { which = 0; W = p.w_in; g0 = p.pre_w; dst = WSP(bf16, O_WTIN); N = DIN; ldk = LDK; kt = t / 31; nt_ = t % 31; }
    else if (t < T_IN + T_OUT) { const int u = t - T_IN; which = 1; W = p.w_out; g0 = p.aon_w; g1 = p.son_w; dst = WSP(bf16, O_WTOUT); N = DM; ldk = DM; kt = u >> 4; nt_ = u & 15; }
    else if (t < T_IN + T_OUT + T_GLU) { const int u = t - T_IN - T_OUT; which = 2; W = p.w_glu; g0 = nullptr; dst = WSP(bf16, O_WTGLU); N = 1024; ldk = DS; kt = u >> 4; nt_ = u & 15; }
    else if (t < T_IN + T_OUT + T_GLU + T_Q) { const int u = t - T_IN - T_OUT - T_GLU; which = 3; W = p.w_qup; g0 = p.qn_w; dst = WSP(bf16, O_WTQ); N = 768; ldk = QL; kt = u / 12; nt_ = u % 12; }
    else { const int u = t - T_IN - T_OUT - T_GLU - T_Q; which = 4; W = p.w_kvup; g0 = p.kvn_w; dst = WSP(bf16, O_WTKV); N = 1024; ldk = KVL; kt = u >> 4; nt_ = u & 15; }
    const int k0 = kt * 64, n0 = nt_ * 64;
#pragma unroll
    for (int i = 0; i < 8; ++i) { const int kk = (tid >> 6) + 8 * i, nn = tid & 63, k = k0 + kk, n = n0 + nn;
      float gk = 1.f; if (which == 1) gk = k < 512 ? g0[k] : g1[k - 512]; else if (g0) gk = g0[k];
      T[kk * 65 + nn] = (n < N) ? W[(size_t)k * N + n] * gk : 0.f; }
    __syncthreads();
    { const int nn = tid >> 3, kc = tid & 7, n = n0 + nn;
      if (n < N) { int row = n; if (which == 2) row = n < 512 ? ((n >> 5) * 64 + (n & 31)) : (((n - 512) >> 5) * 64 + 32 + (n & 31));
        float v[8];
#pragma unroll
        for (int e = 0; e < 8; ++e) v[e] = T[(kc * 8 + e) * 65 + nn];
        u32x4 w = {cvtpk(v[0], v[1]), cvtpk(v[2], v[3]), cvtpk(v[4], v[5]), cvtpk(v[6], v[7])};
        *(u32x4*)(dst + (size_t)row * ldk + k0 + kc * 8) = w; } }
    __syncthreads();
  }
}
__device__ __forceinline__ void prep_all(const P& p, char* lds) {
  const size_t gid = blockIdx.x * (size_t)blockDim.x + threadIdx.x, gsz = gridDim.x * (size_t)blockDim.x;
  prep_transposes(p, lds);
  { float* bglu = WSP(float, O_BGLU);
    for (size_t i = gid; i < 1024; i += gsz) { const int sc = (int)i; const int n = sc < 512 ? ((sc >> 5) * 64 + (sc & 31)) : (((sc - 512) >> 5) * 64 + 32 + (sc & 31)); bglu[n] = p.b_glu[sc]; } }
  { const int lane = threadIdx.x & 63; bf16* xb = WSP(bf16, O_XB); float* rsx = WSP(float, O_RSX);
    for (size_t row = gid >> 6; row < (size_t)RT; row += gsz >> 6) { const float* xr = xrow(p, (int)row); float ss = 0.f;
#pragma unroll
      for (int q = 0; q < 4; ++q) { const f32x4v v = *(const f32x4v*)(xr + q * 256 + lane * 4); ss += v[0] * v[0] + v[1] * v[1] + v[2] * v[2] + v[3] * v[3];
        uint2 w; w.x = cvtpk(v[0], v[1]); w.y = cvtpk(v[2], v[3]); *(uint2*)(xb + row * LDK + q * 256 + lane * 4) = w; }
#pragma unroll
      for (int o = 32; o > 0; o >>= 1) ss += __shfl_xor(ss, o);
      if (lane == 0) rsx[row] = rsqrtf(ss * (1.f / DM) + EPS); } }
  float2* rope = WSP(float2, O_ROPE);
  for (size_t i = gid; i < (size_t)LTOT * 16; i += gsz) {
    int pos = i / 16, j = i % 16; float inv = powf(10000.f, -(float)j / 16.f); float ang = (float)pos * inv;
    float c, s; sincos_red((double)ang, c, s); rope[i] = make_float2(c, s); }
  float2* abar = WSP(float2, O_ABAR); float2* bbar = WSP(float2, O_BBAR);
  for (size_t i = gid; i < 2 * 32 * 64; i += gsz) {
    int dg = i / 64; double dt = exp((double)p.log_dt[dg]); double are = p.a_re[i], aim = p.a_im[i];
    double mag = exp(are * dt); float c, s; sincos_red(aim * dt, c, s);
    double br = mag * (double)c, bi = mag * (double)s;
    br = mag * cos(aim * dt); bi = mag * sin(aim * dt);
    abar[i] = make_float2((float)br, (float)bi);
    { float2* pw = WSP(float2, O_PW) + i * 17;
      double pr = 1.0, pi_ = 0.0;
      for (int d = 0; d <= 16; ++d) { pw[d] = make_float2((float)pr, (float)pi_); const double nr_ = pr * br - pi_ * bi, ni_ = pr * bi + pi_ * br; pr = nr_; pi_ = ni_; } }
    double nr = br - 1.0, ni = bi, den = are * are + aim * aim;
    double cr = (nr * are + ni * aim) / den, ci = (ni * are - nr * aim) / den;
    for (int h = 0; h < 16; ++h) { double b_r = p.b_re[i * 16 + h], b_i = p.b_im[i * 16 + h];
      bbar[i * 16 + h] = make_float2((float)(cr * b_r - ci * b_i), (float)(cr * b_i + ci * b_r)); }
  }
  bf16* kn = WSP(bf16, O_KN); bf16* vv = WSP(bf16, O_V); bf16* kr = WSP(bf16, O_KR);
  for (size_t i = gid; i < (size_t)NB * NH * KPAD * 64; i += gsz) { size_t bh = i / (KPAD * 64), rem = i % (KPAD * 64); kn[bh * NKEY * 64 + rem] = f2bf(0.f); vv[bh * NKEY * 64 + rem] = f2bf(0.f); }
  for (size_t i = gid; i < (size_t)NB * KPAD * 32; i += gsz) { size_t b = i / (KPAD * 32), rem = i % (KPAD * 32); kr[b * NKEY * 32 + rem] = f2bf(0.f); }
}

template <int RB> __device__ __forceinline__ int swz(int row, int chunk) { return row * RB + ((chunk ^ ((row / (256 / RB)) & (RB / 16 - 1))) << 4); }

constexpr int LDS_ROWSS = 131072;
constexpr int LDS_RED = LDS_ROWSS + 1024;
constexpr int LDS_BYTES = LDS_RED + 2048;

struct ALX {
  const float* x; const float* meta;
  struct Raw { f32x4v a, b; };
  __device__ __forceinline__ Raw load(int m, int k) const { m = m < RT ? m : RT - 1;
    const float* r = (m < RX ? x + (size_t)m * DM : meta + (size_t)(m - RX) * DM) + k; Raw v; v.a = *(const f32x4v*)r; v.b = *(const f32x4v*)(r + 4); return v; }
  __device__ __forceinline__ bf16x8 cvt(const Raw& v, int k, float& ss) const {
    ss += v.a[0] * v.a[0] + v.a[1] * v.a[1] + v.a[2] * v.a[2] + v.a[3] * v.a[3] + v.b[0] * v.b[0] + v.b[1] * v.b[1] + v.b[2] * v.b[2] + v.b[3] * v.b[3];
    u32x4 w = {cvtpk(v.a[0], v.a[1]), cvtpk(v.a[2], v.a[3]), cvtpk(v.b[0], v.b[1]), cvtpk(v.b[2], v.b[3])}; return (bf16x8)w; }
};
__device__ __forceinline__ float ss8(u32x4 v) { float s = 0.f;
#pragma unroll
  for (int j = 0; j < 4; ++j) { float a = bflo(v[j]), b = bfhi(v[j]); s += a * a + b * b; } return s; }
struct ALB {
  const bf16* a; int ld; int mmax; using Raw = u32x4;
  __device__ __forceinline__ Raw load(int m, int k) const { m = m < mmax ? m : mmax; return *(const u32x4*)(a + (size_t)m * ld + k); }
  __device__ __forceinline__ bf16x8 cvt(const Raw& v, int k, float& ss) const { ss += ss8(v); return (bf16x8)v; }
};
struct ALBn {
  const bf16* a; int ld; int mmax; using Raw = u32x4;
  __device__ __forceinline__ Raw load(int m, int k) const { m = m < mmax ? m : mmax; return *(const u32x4*)(a + (size_t)m * ld + k); }
  __device__ __forceinline__ bf16x8 cvt(const Raw& v, int k, float& ss) const { return (bf16x8)v; }
};
struct ALOut {
  const bf16* ya; const bf16* ysn; using Raw = u32x4;
  __device__ __forceinline__ Raw load(int m, int k) const { return *(const u32x4*)(k < 512 ? ya + (size_t)m * 512 + k : ysn + (size_t)m * 512 + (k - 512)); }
  __device__ __forceinline__ bf16x8 cvt(const Raw& v, int k, float& ss) const { if (k < 512) ss += ss8(v); return (bf16x8)v; }
};

template <int BM, int BN, int BK, int WGM, int WGN, int MIDKT, class AL>
__device__ __forceinline__ void gemm_main(char* lds, const AL& al, int m0, const bf16* __restrict__ Bt, int ldb, int n0, int nmax, int K,
                                          f32x16 (&acc)[BM / WGM / 32][BN / WGN / 32], const float* midsc = nullptr) {
  constexpr int CPR = BK / 8, RB = BK * 2, RPS = 512 / CPR, A_CH = (BM + RPS - 1) / RPS, B_CH = BN / RPS;
  constexpr int TM = BM / WGM / 32, TN = BN / WGN / 32, A_BYTES = BM * RB, STAGE = (BM + BN) * RB;
  const int tid = otid(), lane = tid & 63, wid = tid >> 6, wm = wid / WGN, wn = wid % WGN, r32 = lane & 31, hi = lane >> 5;
  const int srow = tid / CPR, sch = tid % CPR;
  float* rowss = (float*)(lds + LDS_ROWSS);
  typename AL::Raw ra[A_CH]; u32x4 rb[B_CH]; float ss[A_CH];
#pragma unroll
  for (int i = 0; i < A_CH; ++i) ss[i] = 0.f;
#pragma unroll
  for (int i = 0; i < TM; ++i)
#pragma unroll
    for (int j = 0; j < TN; ++j)
#pragma unroll
      for (int r = 0; r < 16; ++r) acc[i][j][r] = 0.f;
#define GLOAD(kt) do { const int k_ = (kt) * BK + sch * 8; \
    _Pragma("unroll") for (int i = 0; i < A_CH; ++i) if (BM % RPS == 0 || srow + i * RPS < BM) ra[i] = al.load(m0 + srow + i * RPS, k_); \
    _Pragma("unroll") for (int i = 0; i < B_CH; ++i) { int n_ = n0 + srow + i * RPS; n_ = n_ < nmax ? n_ : nmax; rb[i] = *(const u32x4*)(Bt + (size_t)n_ * ldb + k_); } } while (0)
#define SWRITE(buf, kt) do { char* base_ = lds + (buf) * STAGE; const int k_ = (kt) * BK + sch * 8; \
    _Pragma("unroll") for (int i = 0; i < A_CH; ++i) if (BM % RPS == 0 || srow + i * RPS < BM) *(bf16x8*)(base_ + swz<RB>(srow + i * RPS, sch)) = al.cvt(ra[i], k_, ss[i]); \
    _Pragma("unroll") for (int i = 0; i < B_CH; ++i) *(u32x4*)(base_ + A_BYTES + swz<RB>(srow + i * RPS, sch)) = rb[i]; } while (0)
#define PUBSS() do { \
    _Pragma("unroll") for (int i = 0; i < A_CH; ++i) { float s_ = ss[i]; \
      _Pragma("unroll") for (int o = 1; o < CPR; o <<= 1) s_ += __shfl_xor(s_, o); \
      if (sch == 0 && (BM % RPS == 0 || srow + i * RPS < BM)) rowss[srow + i * RPS] = s_; } \
    __syncthreads(); } while (0)
  const int nk = K / BK;
  GLOAD(0); SWRITE(0, 0); __syncthreads();
#pragma unroll 1
  for (int kt = 0; kt < nk; ++kt) {
    if (kt + 1 < nk) GLOAD(kt + 1);
    if (MIDKT >= 0 && kt == MIDKT) {
      PUBSS();
#pragma unroll
      for (int i = 0; i < TM; ++i)
      { float rs = rsqrtf(rowss[wm * (TM * 32) + i * 32 + r32] * (1.f / 512.f) + EPS); if (midsc) rs *= midsc[wm * (TM * 32) + i * 32 + r32];
#pragma unroll
        for (int j = 0; j < TN; ++j)
#pragma unroll
          for (int r = 0; r < 16; ++r) acc[i][j][r] *= rs; }
    }
    const char* base = lds + (kt & 1) * STAGE;
#pragma unroll
    for (int ks = 0; ks < BK / 16; ++ks) {
      bf16x8 af[TM], bfr[TN];
#pragma unroll
      for (int i = 0; i < TM; ++i) af[i] = *(const bf16x8*)(base + swz<RB>(wm * (TM * 32) + i * 32 + r32, ks * 2 + hi));
#pragma unroll
      for (int j = 0; j < TN; ++j) bfr[j] = *(const bf16x8*)(base + A_BYTES + swz<RB>(wn * (TN * 32) + j * 32 + r32, ks * 2 + hi));
#pragma unroll
      for (int i = 0; i < TM; ++i)
#pragma unroll
        for (int j = 0; j < TN; ++j) acc[i][j] = __builtin_amdgcn_mfma_f32_32x32x16_bf16(bfr[j], af[i], acc[i][j], 0, 0, 0);
    }
    if (kt + 1 < nk) SWRITE((kt + 1) & 1, kt + 1);
    __syncthreads();
  }
  if (MIDKT < 0) PUBSS();
#undef GLOAD
#undef SWRITE
#undef PUBSS
}

__device__ __forceinline__ int row_pos(int m) { return m < RX ? (m & (SEQ - 1)) + NMETA : m - RX; }
__device__ __forceinline__ uint2 pack4(float a, float b, float c, float d) { uint2 w; w.x = cvtpk(a, b); w.y = cvtpk(c, d); return w; }
__device__ __forceinline__ void rope_block(f32x16& v, const float2* rope_pos, int hi) {
#pragma unroll
  for (int g = 0; g < 2; ++g)
#pragma unroll
    for (int e = 0; e < 4; ++e) { const int r = 4 * g + e; const float2 cs = rope_pos[8 * g + 4 * hi + e];
      const float x1 = v[r], x2 = v[r + 8]; v[r] = x1 * cs.x - x2 * cs.y; v[r + 8] = x1 * cs.y + x2 * cs.x; }
}

constexpr int NT_INPROJ = 5 * 256;
__device__ __forceinline__ void inproj_xform(const P& p, f32x16& a, int m, int nb, int hi, float rs) {
#pragma unroll
  for (int r = 0; r < 16; ++r) a[r] *= rs;
  if (nb == 384) rope_block(a, WSP(float2, O_ROPE) + row_pos(m < RT ? m : RT - 1) * 16, hi);
  else if ((nb >= 416 && nb < 928) || nb >= 1440) {
#pragma unroll
    for (int r = 0; r < 16; ++r) a[r] = silu(a[r]); }
}
constexpr int EP_RS = 144;
__device__ __forceinline__ void inproj_rows(const P& p, char* wl, f32x16& a0, f32x16& a1, int mrow0, int nb0, int lane, int r32, int hi) {
  const int m = mrow0 + r32; const float rs = WSP(float, O_RSX)[m < RT ? m : RT - 1];
  inproj_xform(p, a0, m, nb0, hi, rs); inproj_xform(p, a1, m, nb0 + 32, hi, rs);
#pragma unroll
  for (int g = 0; g < 4; ++g) {
    *(uint2*)(wl + r32 * EP_RS + (8 * g + 4 * hi) * 2) = pack4(a0[4 * g], a0[4 * g + 1], a0[4 * g + 2], a0[4 * g + 3]);
    *(uint2*)(wl + r32 * EP_RS + (32 + 8 * g + 4 * hi) * 2) = pack4(a1[4 * g], a1[4 * g + 1], a1[4 * g + 2], a1[4 * g + 3]); }
#pragma unroll
  for (int it = 0; it < 4; ++it) {
    const int row = it * 8 + (lane >> 3), ch = lane & 7, mm = mrow0 + row, n = nb0 + ch * 8;
    const u32x4 v = *(const u32x4*)(wl + row * EP_RS + ch * 16);
    if (n >= DIN || mm >= RT) continue;
    bf16* dst;
    if (n < 256) dst = WSP(bf16, O_QLAT) + (size_t)mm * QL + n;
    else if (n < 384) dst = WSP(bf16, O_KVLAT) + (size_t)mm * KVL + (n - 256);
    else if (n < 416) { const int pos = row_pos(mm), c = n - 384; bf16* kr = WSP(bf16, O_KR);
      if (mm < RX) dst = kr + ((size_t)(mm >> 14) * NKEY + KPAD + pos) * 32 + c;
      else { *(u32x4*)(kr + ((size_t)NKEY + KPAD + pos) * 32 + c) = v; dst = kr + ((size_t)KPAD + pos) * 32 + c; } }
    else if (n < 928) { if (mm >= RX) continue; dst = WSP(bf16, O_AGATE) + (size_t)mm * DA + (n - 416); }
    else if (n < 1440) { const int c = n - 928; dst = WSP(bf16, O_SUG) + ((size_t)(c >> 4) * RP + mm) * GH + (c & 15); }
    else { if (mm >= RX) continue; dst = WSP(bf16, O_SGATE) + (size_t)mm * DS + (n - 1440); }
    *(u32x4*)dst = v;
  }
}
__device__ __forceinline__ void phase_inproj(const P& p, int tile, char* lds) {
  const int rnd = tile >> 8, s = tile & 255, xcd = s & 7, slot = s >> 3;
  const int mt = rnd * 32 + xcd * 4 + (slot >> 3), nt = slot & 7;
  if (mt > 128) return;
  const int m0 = mt * 256, n0 = nt * 256;
  f32x16 acc[4][2]; ALBn al{WSP(bf16, O_XB), LDK, RT - 1};
  gemm_main<256, 256, 64, 2, 4, -1>(lds, al, m0, WSP(bf16, O_WTIN), LDK, n0, DIN - 1, DM, acc);
  const int tid_ = otid(), lane = tid_ & 63, wid = tid_ >> 6, wm = wid >> 2, wn = wid & 3, r32 = lane & 31, hi = lane >> 5;
  const int mw = m0 + wm * 128, nb = n0 + wn * 64; char* wl = lds + wid * (32 * EP_RS);
  inproj_rows(p, wl, acc[0][0], acc[0][1], mw, nb, lane, r32, hi);
  inproj_rows(p, wl, acc[1][0], acc[1][1], mw + 32, nb, lane, r32, hi);
  inproj_rows(p, wl, acc[2][0], acc[2][1], mw + 64, nb, lane, r32, hi);
  inproj_rows(p, wl, acc[3][0], acc[3][1], mw + 96, nb, lane, r32, hi);
  __syncthreads();
}
constexpr int NT_QUP = (RX / 256) * 3, NT_KVUP = (RP / 256) * 4;
__device__ __forceinline__ void qup_epi(const P& p, f32x16 a, int m, int nb, int hi, float rs) {
  const int h = nb / DQK, c0 = nb % DQK, b = m >> 14, ii = m & (SEQ - 1);
#pragma unroll
  for (int r = 0; r < 16; ++r) a[r] *= rs;
  if (c0 == 64) rope_block(a, WSP(float2, O_ROPE) + (ii + NMETA) * 16, hi);
  bf16* dst = WSP(bf16, O_Q) + (((size_t)b * NH + h) * SEQ + ii) * DQK + c0 + 4 * hi;
#pragma unroll
  for (int g = 0; g < 4; ++g) *(uint2*)(dst + 8 * g) = pack4(a[4 * g], a[4 * g + 1], a[4 * g + 2], a[4 * g + 3]);
}
__device__ __forceinline__ void phase_qup(const P& p, int tile, char* lds) {
  const int mt = tile / 3, nt = tile % 3, m0 = mt * 256, n0 = nt * 256;
  f32x16 acc[4][2]; ALB al{WSP(bf16, O_QLAT), QL, RT - 1};
  gemm_main<256, 256, 64, 2, 4, -1>(lds, al, m0, WSP(bf16, O_WTQ), QL, n0, 767, QL, acc);
  const int tid_ = otid(), lane = tid_ & 63, wid = tid_ >> 6, wm = wid >> 2, wn = wid & 3, r32 = lane & 31, hi = lane >> 5;
  const float* rowss = (const float*)(lds + LDS_ROWSS); const int lr = wm * 128 + r32, nb = n0 + wn * 64;
  constexpr float QC = 0.10206207261596577f * 1.4426950408889634f;
#define QROW(i) do { const float rs_ = rsqrtf(rowss[lr + 32 * (i)] * (1.f / QL) + EPS) * QC; qup_epi(p, acc[i][0], m0 + lr + 32 * (i), nb, hi, rs_); qup_epi(p, acc[i][1], m0 + lr + 32 * (i), nb + 32, hi, rs_); } while (0)
  QROW(0); QROW(1); QROW(2); QROW(3);
#undef QROW
  __syncthreads();
}
__device__ __forceinline__ void kvup_epi(const P& p, const f32x16& a, int m, int nb, int hi, float rs) {
  if (m >= RT) return;
  const int h = nb >> 7, c0 = nb & 127; bf16* base = c0 < 64 ? WSP(bf16, O_KN) : WSP(bf16, O_V); const int c = (c0 & 63) + 4 * hi;
#pragma unroll
  for (int g = 0; g < 4; ++g) { const uint2 w = pack4(a[4 * g] * rs, a[4 * g + 1] * rs, a[4 * g + 2] * rs, a[4 * g + 3] * rs);
    if (m < RX) *(uint2*)(base + (((size_t)(m >> 14) * NH + h) * NKEY + KPAD + NMETA + (m & (SEQ - 1))) * 64 + c + 8 * g) = w;
    else { const int jk = KPAD + (m - RX); *(uint2*)(base + ((size_t)h * NKEY + jk) * 64 + c + 8 * g) = w; *(uint2*)(base + (((size_t)NH + h) * NKEY + jk) * 64 + c + 8 * g) = w; } }
}
__device__ __forceinline__ void phase_kvup(const P& p, int tile, char* lds) {
  const int mt = tile >> 2, nt = tile & 3, m0 = mt * 256, n0 = nt * 256;
  f32x16 acc[4][2]; ALB al{WSP(bf16, O_KVLAT), KVL, RT - 1};
  gemm_main<256, 256, 64, 2, 4, -1>(lds, al, m0, WSP(bf16, O_WTKV), KVL, n0, 1023, KVL, acc);
  const int tid_ = otid(), lane = tid_ & 63, wid = tid_ >> 6, wm = wid >> 2, wn = wid & 3, r32 = lane & 31, hi = lane >> 5;
  const float* rowss = (const float*)(lds + LDS_ROWSS); const int lr = wm * 128 + r32, nb = n0 + wn * 64;
#define KVROW(i) do { const float rs_ = rsqrtf(rowss[lr + 32 * (i)] * (1.f / KVL) + EPS); kvup_epi(p, acc[i][0], m0 + lr + 32 * (i), nb, hi, rs_); kvup_epi(p, acc[i][1], m0 + lr + 32 * (i), nb + 32, hi, rs_); } while (0)
  KVROW(0); KVROW(1); KVROW(2); KVROW(3);
#undef KVROW
  __syncthreads();
}
__device__ __forceinline__ float pair_sum(float v) { return v + __shfl_xor(v, 32); }
constexpr int NT_GLU = 512;
__device__ __forceinline__ void glu_epi(const P& p, const f32x16& av, const f32x16& ag, int m, int q, int hi) {
  const float* bg = WSP(float, O_BGLU); const bf16* sg = WSP(bf16, O_SGATE); bf16* yrow = WSP(bf16, O_YSN) + (size_t)m * DS + q * 32; float part = 0.f;
#pragma unroll
  for (int g = 0; g < 4; ++g) { const int cc = 8 * g + 4 * hi; const f32x4v ba = *(const f32x4v*)(bg + q * 64 + cc), bgt = *(const f32x4v*)(bg + q * 64 + 32 + cc);
    const uint2 gw = *(const uint2*)(sg + (size_t)m * DS + q * 32 + cc); const float gt[4] = {bflo(gw.x), bfhi(gw.x), bflo(gw.y), bfhi(gw.y)}; float v[4];
#pragma unroll
    for (int e = 0; e < 4; ++e) { const float a_ = av[4 * g + e] + ba[e], g_ = ag[4 * g + e] + bgt[e]; v[e] = a_ / (1.f + __expf(-g_)) * gt[e]; part += v[e] * v[e]; }
    *(uint2*)(yrow + cc) = pack4(v[0], v[1], v[2], v[3]); }
  part = pair_sum(part);
  if (hi == 0) WSP(float, O_GPART)[(size_t)q * RX + m] = part;
}
__device__ __forceinline__ void phase_glu(const P& p, int tile, char* lds) {
  const int rnd = tile >> 8, s = tile & 255, xcd = s & 7, slot = s >> 3, mt = rnd * 64 + xcd * 8 + (slot >> 2), nt = slot & 3, m0 = mt * 256;
  f32x16 acc[4][2]; ALBn al{WSP(bf16, O_YSG), DS, RX - 1};
  gemm_main<256, 256, 64, 2, 4, -1>(lds, al, m0, WSP(bf16, O_WTGLU), DS, nt * 256, 1023, DS, acc);
  const int tid_ = otid(), lane = tid_ & 63, wid = tid_ >> 6, wm = wid >> 2, wn = wid & 3, r32 = lane & 31, hi = lane >> 5;
  const int m = m0 + wm * 128 + r32, q = nt * 4 + wn;
  glu_epi(p, acc[0][0], acc[0][1], m, q, hi); glu_epi(p, acc[1][0], acc[1][1], m + 32, q, hi);
  glu_epi(p, acc[2][0], acc[2][1], m + 64, q, hi); glu_epi(p, acc[3][0], acc[3][1], m + 96, q, hi);
  __syncthreads();
}
constexpr int NT_OUT = 512;
__device__ __forceinline__ float out_epi(const P& p, const f32x16& a, int m, int nb, int hi, float sc) {
  bf16* yrow = WSP(bf16, O_Y) + (size_t)m * DM + nb + 4 * hi; float part = 0.f;
#pragma unroll
  for (int g = 0; g < 4; ++g) { const float v0 = a[4 * g] * sc, v1 = a[4 * g + 1] * sc, v2 = a[4 * g + 2] * sc, v3 = a[4 * g + 3] * sc;
    part += v0 * v0 + v1 * v1 + v2 * v2 + v3 * v3; *(uint2*)(yrow + 8 * g) = pack4(v0, v1, v2, v3); }
  return part;
}
__device__ __forceinline__ void phase_out(const P& p, int tile, char* lds) {
  const int rnd = tile >> 8, s = tile & 255, xcd = s & 7, slot = s >> 3, mt = rnd * 64 + xcd * 8 + (slot >> 2), nt = slot & 3, m0 = mt * 256;
  float* isc = (float*)(lds + LDS_RED);
  { const int t = otid(); if (t < 256) { const float* gp = WSP(float, O_GPART) + m0 + t; float sq = 0.f;
#pragma unroll
      for (int q = 0; q < 16; ++q) sq += gp[(size_t)q * RX];
      isc[t] = sqrtf(sq * (1.f / DS) + EPS); } }
  __syncthreads();
  f32x16 acc[4][2]; ALOut al{WSP(bf16, O_YA), WSP(bf16, O_YSN)};
  gemm_main<256, 256, 64, 2, 4, 8>(lds, al, m0, WSP(bf16, O_WTOUT), DM, nt * 256, 1023, DM, acc, isc);
  const int tid_ = otid(), lane = tid_ & 63, wid = tid_ >> 6, wm = wid >> 2, wn = wid & 3, r32 = lane & 31, hi = lane >> 5;
  const int lr = wm * 128 + r32, m = m0 + lr, nb = nt * 256 + wn * 64; float* yp = WSP(float, O_YPART) + (size_t)(nt * 4 + wn) * RX;
#define OUT_ROW(i) do { const float sc_ = 1.f / isc[lr + 32 * (i)]; float part_ = out_epi(p, acc[i][0], m + 32 * (i), nb, hi, sc_) + out_epi(p, acc[i][1], m + 32 * (i), nb + 32, hi, sc_); \
    part_ = pair_sum(part_); if (hi == 0) yp[m + 32 * (i)] = part_; } while (0)
  OUT_ROW(0); OUT_ROW(1); OUT_ROW(2); OUT_ROW(3);
#undef OUT_ROW
  __syncthreads();
}
__device__ __forceinline__ void phase_final(const P& p) {
  const int t = threadIdx.x, rsub = t >> 7, c = (t & 127) * 8; const float* yp = WSP(float, O_YPART);
  const f32x4v w0 = *(const f32x4v*)(p.post_w + c), w1 = *(const f32x4v*)(p.post_w + c + 4);
  for (int row = blockIdx.x * 4 + rsub; row < RX; row += gridDim.x * 4) {
    float sq = 0.f;
#pragma unroll
    for (int q = 0; q < 16; ++q) sq += yp[(size_t)q * RX + row];
    const float rs = rsqrtf(sq * (1.f / DM) + EPS);
    const u32x4 yv = *(const u32x4*)(WSP(bf16, O_Y) + (size_t)row * DM + c);
    const f32x4v x0 = *(const f32x4v*)(p.x + (size_t)row * DM + c), x1 = *(const f32x4v*)(p.x + (size_t)row * DM + c + 4);
    f32x4v o0, o1;
    o0[0] = x0[0] + bflo(yv[0]) * rs * w0[0]; o0[1] = x0[1] + bfhi(yv[0]) * rs * w0[1]; o0[2] = x0[2] + bflo(yv[1]) * rs * w0[2]; o0[3] = x0[3] + bfhi(yv[1]) * rs * w0[3];
    o1[0] = x1[0] + bflo(yv[2]) * rs * w1[0]; o1[1] = x1[1] + bfhi(yv[2]) * rs * w1[1]; o1[2] = x1[2] + bflo(yv[3]) * rs * w1[2]; o1[3] = x1[3] + bfhi(yv[3]) * rs * w1[3];
    *(f32x4v*)(p.out + (size_t)row * DM + c) = o0; *(f32x4v*)(p.out + (size_t)row * DM + c + 4) = o1;
  }
}

using s16x4 = __attribute__((ext_vector_type(4))) short;
constexpr float ATT_SCALE = 0.10206207261596577f;
constexpr float ATT_THR = 8.f;
constexpr int A_SHM_V = 8192, A_SHM_KN = 8192, A_SHM_KR = 4096;
constexpr int A_OFF_V = 0, A_OFF_KN = 2 * A_SHM_V, A_OFF_KR = A_OFF_KN + 2 * A_SHM_KN, A_OFF_WS = A_OFF_KR + 2 * A_SHM_KR;
#define SBAR() __builtin_amdgcn_sched_barrier(0)
__device__ __forceinline__ unsigned cvtpkv(float lo, float hi) { unsigned r; asm volatile("v_cvt_pk_bf16_f32 %0, %1, %2" : "=v"(r) : "v"(lo), "v"(hi)); return r; }
constexpr float ATT_THR2 = 60.f;
__device__ __forceinline__ float rowmaxSM(const f32x16& p0, const f32x16& p1) {
  float pmax = p0[0];
#pragma unroll
  for (int r = 1; r < 16; ++r) pmax = fmaxf(pmax, p0[r]);
#pragma unroll
  for (int r = 0; r < 16; ++r) pmax = fmaxf(pmax, p1[r]);
  auto rr = __builtin_amdgcn_permlane32_swap(__float_as_uint(pmax), __float_as_uint(pmax), false, false);
  return fmaxf(__uint_as_float(rr[0]), __uint_as_float(rr[1]));
}
__device__ __forceinline__ void decideSM(f32x16& p0, f32x16& p1, float pmax, float& m_reg, float& alpha, bool& zref) {
  if (__builtin_expect(__all(pmax <= ATT_THR2), 1)) { alpha = 1.f; }
  else { const float delta = fmaxf(pmax, 0.f); alpha = __builtin_amdgcn_exp2f(-delta); m_reg += delta; zref = false;
#pragma unroll
    for (int r = 0; r < 16; ++r) { p0[r] -= delta; p1[r] -= delta; } }
#pragma unroll
  for (int r = 0; r < 16; ++r) p0[r] = __builtin_amdgcn_exp2f(p0[r]);
}
__device__ __forceinline__ void firstSM(f32x16& p0, f32x16& p1, float pmax, float& m_reg, float& alpha, bool& zref) {
  alpha = 1.f;
  if (!__all(fabsf(pmax) <= ATT_THR2)) { const float delta = fabsf(pmax) <= ATT_THR2 ? 0.f : pmax; m_reg = delta; zref = false;
#pragma unroll
    for (int r = 0; r < 16; ++r) { p0[r] -= delta; p1[r] -= delta; } }
#pragma unroll
  for (int r = 0; r < 16; ++r) p0[r] = __builtin_amdgcn_exp2f(p0[r]);
}
#define SCHEDPAT() do { _Pragma("unroll") for (int i_ = 0; i_ < 10; ++i_) { __builtin_amdgcn_sched_group_barrier(0x008, 2, 0); __builtin_amdgcn_sched_group_barrier(0x100, 4, 0); __builtin_amdgcn_sched_group_barrier(0x002, 9, 0); } } while (0)
__device__ __forceinline__ void finishSM(f32x16& p0, f32x16& p1, float alpha, float& l_reg, bf16x8& pa0, bf16x8& pa1, bf16x8& pa2, bf16x8& pa3) {
#pragma unroll
  for (int r = 0; r < 16; ++r) p1[r] = __builtin_amdgcn_exp2f(p1[r]);
  float ps = 0;
#pragma unroll
  for (int r = 0; r < 16; ++r) ps += p0[r];
#pragma unroll
  for (int r = 0; r < 16; ++r) ps += p1[r];
  { auto rr = __builtin_amdgcn_permlane32_swap(__float_as_uint(ps), __float_as_uint(ps), false, false);
    ps = __uint_as_float(rr[0]) + __uint_as_float(rr[1]); }
  l_reg = l_reg * alpha + ps;
#define PK4(Pv, BASE, OUT) do { u32x4 w = {cvtpkv(Pv[BASE + 0], Pv[BASE + 1]), cvtpkv(Pv[BASE + 2], Pv[BASE + 3]), cvtpkv(Pv[BASE + 4], Pv[BASE + 5]), cvtpkv(Pv[BASE + 6], Pv[BASE + 7])}; \
    OUT = (bf16x8)w; } while (0)
  PK4(p0, 0, pa0); PK4(p0, 8, pa1); PK4(p1, 0, pa2); PK4(p1, 8, pa3);
#undef PK4
}
__device__ __forceinline__ void qkt(f32x16& p0, f32x16& p1, const char* Kn, const char* Kr, const bf16x8* qr, int r32, int hi, float init) {
#pragma unroll
  for (int r = 0; r < 16; ++r) { p0[r] = init; p1[r] = init; }
#pragma unroll
  for (int d0 = 0; d0 < 4; ++d0) {
    bf16x8 b0 = *(const bf16x8*)(Kn + swz<128>(r32, d0 * 2 + hi));
    bf16x8 b1 = *(const bf16x8*)(Kn + swz<128>(32 + r32, d0 * 2 + hi));
    p0 = __builtin_amdgcn_mfma_f32_32x32x16_bf16(b0, qr[d0], p0, 0, 0, 0);
    p1 = __builtin_amdgcn_mfma_f32_32x32x16_bf16(b1, qr[d0], p1, 0, 0, 0); }
#pragma unroll
  for (int d0 = 0; d0 < 2; ++d0) {
    bf16x8 b0 = *(const bf16x8*)(Kr + swz<64>(r32, d0 * 2 + hi));
    bf16x8 b1 = *(const bf16x8*)(Kr + swz<64>(32 + r32, d0 * 2 + hi));
    p0 = __builtin_amdgcn_mfma_f32_32x32x16_bf16(b0, qr[4 + d0], p0, 0, 0, 0);
    p1 = __builtin_amdgcn_mfma_f32_32x32x16_bf16(b1, qr[4 + d0], p1, 0, 0, 0); }
}
__device__ __forceinline__ int v_st(int k, int c) { const int kk = k;     return ((kk >> 3) * 2 + (c >> 5)) * 512 + ((kk & 7) * 32 + (c & 31)) * 2; }
__device__ __forceinline__ int v_rd_base(int lane) { return ((lane & 3) << 3) | (((lane >> 2) & 3) << 6) | (((lane >> 4) & 1) << 5) | (((lane >> 5) & 1) << 8); }
constexpr int v_rd_off(int d0, int ks, int half) { return d0 * 512 + ks * 2048 + half * 1024; }
template <int OFF> __device__ __forceinline__ s16x4 tr_read(int vb) {
  return __builtin_amdgcn_ds_read_tr16_b64_v4i16((__attribute__((address_space(3))) s16x4*)(uintptr_t)(unsigned)(vb + OFF));
}
template <int D0> __device__ __forceinline__ void pv_one(f32x16& od, int vb, bf16x8 pa0, bf16x8 pa1, bf16x8 pa2, bf16x8 pa3) {
  const s16x4 l0 = tr_read<v_rd_off(D0, 0, 0)>(vb), h0 = tr_read<v_rd_off(D0, 0, 1)>(vb), l1 = tr_read<v_rd_off(D0, 1, 0)>(vb), h1 = tr_read<v_rd_off(D0, 1, 1)>(vb);
  const s16x4 l2 = tr_read<v_rd_off(D0, 2, 0)>(vb), h2 = tr_read<v_rd_off(D0, 2, 1)>(vb), l3 = tr_read<v_rd_off(D0, 3, 0)>(vb), h3 = tr_read<v_rd_off(D0, 3, 1)>(vb);
#define PKV(L, H) (bf16x8){L[0], L[1], L[2], L[3], H[0], H[1], H[2], H[3]}
  od = __builtin_amdgcn_mfma_f32_32x32x16_bf16(PKV(l0, h0), pa0, od, 0, 0, 0);
  od = __builtin_amdgcn_mfma_f32_32x32x16_bf16(PKV(l1, h1), pa1, od, 0, 0, 0);
  od = __builtin_amdgcn_mfma_f32_32x32x16_bf16(PKV(l2, h2), pa2, od, 0, 0, 0);
  od = __builtin_amdgcn_mfma_f32_32x32x16_bf16(PKV(l3, h3), pa3, od, 0, 0, 0);
#undef PKV
}
constexpr int NT_ATTN = NB * NH * (SEQ / 256);
constexpr int ATT_NT = NKEY / 64;
#ifndef ATT_FORCE_FALLBACK
#define ATT_FORCE_FALLBACK 0
#endif
template <bool FAST> __device__ __forceinline__ void attn_item(const P& p, int item, char* lds) {
  const int rnd = item >> 8, s = item & 255, xcd = s & 7, idx = s >> 3;
  const int bh = rnd * 4 + (xcd >> 1), qblk = (xcd & 1) * 32 + idx, b = bh >> 3, h = bh & 7, i0 = qblk * 256;
  const int tid = otid(), wid = tid >> 6, lane = tid & 63, r32 = lane & 31, hi = lane >> 5;
  const bf16* Qb = WSP(bf16, O_Q) + ((size_t)bh * SEQ + i0) * DQK;
  const bf16* Knh = WSP(bf16, O_KN) + (size_t)bh * NKEY * 64; const bf16* Vh = WSP(bf16, O_V) + (size_t)bh * NKEY * 64;
  const bf16* Krb = WSP(bf16, O_KR) + (size_t)b * NKEY * 32;
  char* V_lds = lds + A_OFF_V; char* Kn_lds = lds + A_OFF_KN; char* Kr_lds = lds + A_OFF_KR;
  volatile unsigned* redo = (volatile unsigned*)(lds + A_OFF_WS);
  if (FAST && tid == 0) *redo = 0u;
  float m_reg = 0.f, l_reg = 0; bool zref = true; f32x16 o[2]; bf16x8 qr[6];
#pragma unroll
  for (int r = 0; r < 16; ++r) { o[0][r] = 0.f; o[1][r] = 0.f; }
  const bf16* Qw = Qb + (size_t)(wid * 32 + r32) * DQK + hi * 8;
#pragma unroll
  for (int d0 = 0; d0 < 6; ++d0) qr[d0] = *(const bf16x8*)(Qw + d0 * 16);
  const int sr = tid >> 3, sc = tid & 7;
  const int vst = v_st(sr, sc * 8), knst = swz<128>(sr, sc), krst = swz<64>(sr, sc >> 1) + (sc & 1) * 8;
  const int vb0 = (int)(uintptr_t)V_lds + v_rd_base(lane);
  struct { u32x4 v, kn; uint2 kr; } st_[2];
#define SLOAD(i, k0) do { st_[i].v = *(const u32x4*)(Vh + (size_t)((k0) + sr) * 64 + sc * 8); st_[i].kn = *(const u32x4*)(Knh + (size_t)((k0) + sr) * 64 + sc * 8); \
    st_[i].kr = *(const uint2*)(Krb + (size_t)((k0) + sr) * 32 + sc * 4); } while (0)
#define SWRITE(bq, i) do { *(u32x4*)(V_lds + (bq) * A_SHM_V + vst) = st_[i].v; *(u32x4*)(Kn_lds + (bq) * A_SHM_KN + knst) = st_[i].kn; \
    *(uint2*)(Kr_lds + (bq) * A_SHM_KR + krst) = st_[i].kr; } while (0)
#define SWAIT() asm volatile("s_waitcnt vmcnt(3)" ::: "memory")
#define RESC(a) do { if (__any((a) < 1.f)) { _Pragma("unroll") for (int d = 0; d < 2; ++d) _Pragma("unroll") for (int r = 0; r < 16; ++r) o[d][r] *= (a); } } while (0)
#define PV(vbx) do { pv_one<0>(o[0], (vbx), pa0, pa1, pa2, pa3); pv_one<1>(o[1], (vbx), pa0, pa1, pa2, pa3); } while (0)
  f32x16 pA0, pA1, pB0, pB1; float alA, alB; bf16x8 pa0, pa1, pa2, pa3; constexpr int NT = ATT_NT;
  constexpr int SE = 0, SO = 1;
  if (wid >= 4) __builtin_amdgcn_s_setprio(1);
  SLOAD(SE, 0); asm volatile("s_waitcnt vmcnt(0)" ::: "memory"); SWRITE(0, SE); __syncthreads();
  qkt(pA0, pA1, Kn_lds, Kr_lds, qr, r32, hi, 0.f);
#pragma unroll
  for (int r = 0; r < 16; ++r) pA0[r] = -1e30f;
#pragma unroll
  for (int r = 0; r < 8; ++r) pA1[r] = -1e30f;
  { const float pm_ = rowmaxSM(pA0, pA1); firstSM(pA0, pA1, pm_, m_reg, alA, zref); }
  bool bad = FAST && !zref;
  SLOAD(SO, 64); SLOAD(SE, 128);
  SWAIT(); SWRITE(1, SO); __syncthreads();
  for (int j = 1; j + 1 < NT; j += 2) {
    if (FAST || zref) qkt(pB0, pB1, Kn_lds + A_SHM_KN, Kr_lds + A_SHM_KR, qr, r32, hi, 0.f); else qkt(pB0, pB1, Kn_lds + A_SHM_KN, Kr_lds + A_SHM_KR, qr, r32, hi, -m_reg);
    finishSM(pA0, pA1, alA, l_reg, pa0, pa1, pa2, pa3);
    SLOAD(SO, (j + 2 < NT ? j + 2 : NT - 1) * 64);
    PV(vb0);
    if (FAST) { SCHEDPAT(); alB = 1.f; _Pragma("unroll") for (int r = 0; r < 16; ++r) pB0[r] = __builtin_amdgcn_exp2f(pB0[r]); }
    else { const float pm_ = rowmaxSM(pB0, pB1); SCHEDPAT(); decideSM(pB0, pB1, pm_, m_reg, alB, zref); }
    __syncthreads(); SWAIT(); SWRITE(0, SE);
    if (!FAST) RESC(alB);
    __syncthreads();
    if (FAST || zref) qkt(pA0, pA1, Kn_lds, Kr_lds, qr, r32, hi, 0.f); else qkt(pA0, pA1, Kn_lds, Kr_lds, qr, r32, hi, -m_reg);
    finishSM(pB0, pB1, alB, l_reg, pa0, pa1, pa2, pa3);
    SLOAD(SE, (j + 3 < NT ? j + 3 : NT - 1) * 64);
    PV(vb0 + A_SHM_V);
    if (FAST) { SCHEDPAT(); alA = 1.f; _Pragma("unroll") for (int r = 0; r < 16; ++r) pA0[r] = __builtin_amdgcn_exp2f(pA0[r]); }
    else { const float pm_ = rowmaxSM(pA0, pA1); SCHEDPAT(); decideSM(pA0, pA1, pm_, m_reg, alA, zref); }
    __syncthreads(); SWAIT(); SWRITE(1, SO);
    if (!FAST) RESC(alA);
    __syncthreads();
  }
  __builtin_amdgcn_s_setprio(0);
  finishSM(pA0, pA1, alA, l_reg, pa0, pa1, pa2, pa3); SBAR();
  PV(vb0);
  if (FAST) { float chk = l_reg;
#pragma unroll
    for (int r = 0; r < 16; ++r) chk += fabsf(o[0][r]) + fabsf(o[1][r]);
    bad = bad || !(chk < 3.0e38f) || !(l_reg > 0.f) ; if (ATT_FORCE_FALLBACK) { int one_ = 1; asm volatile("" : "+v"(one_)); bad = bad || (one_ != 0); }
    if (__any(bad) && lane == 0) *redo = 1u; }
  { const float rl = __builtin_amdgcn_rcpf(l_reg); const size_t rowoff = (size_t)(b * SEQ + i0 + wid * 32 + r32) * DA + h * 64 + 4 * hi;
    const bf16* gate = WSP(bf16, O_AGATE) + rowoff; bf16* ya = WSP(bf16, O_YA) + rowoff;
#pragma unroll
    for (int d0 = 0; d0 < 2; ++d0)
#pragma unroll
      for (int g = 0; g < 4; ++g) { const uint2 gw = *(const uint2*)(gate + d0 * 32 + 8 * g);
        *(uint2*)(ya + d0 * 32 + 8 * g) = pack4(o[d0][4 * g] * rl * bflo(gw.x), o[d0][4 * g + 1] * rl * bfhi(gw.x), o[d0][4 * g + 2] * rl * bflo(gw.y), o[d0][4 * g + 3] * rl * bfhi(gw.y)); } }
  __syncthreads();
  bool again = false; if (FAST) { again = (*redo != 0u); __syncthreads(); }
#undef SLOAD
#undef SWRITE
#undef SWAIT
#undef RESC
#undef PV
  if (FAST) { if (again) attn_item<false>(p, item, lds); }
}


__device__ __forceinline__ void build_tables_p1(const P& p) {
  const size_t gid = blockIdx.x * 512ull + threadIdx.x, gsz = gridDim.x * 512ull;
  const float2* pw = WSP(float2, O_PW); const float2* bbar = WSP(float2, O_BBAR); float* Kt = WSP(float, O_KT); bf16* WS = WSP(bf16, O_WS);
  for (size_t i = gid; i < (size_t)2 * 32 * 16 * 256; i += gsz) { const int h = i & 15, hp = (i >> 4) & 15, d = (i >> 8) & 15, dg = i >> 12;
    float s = 0.f;
#pragma unroll 8
    for (int pp = 0; pp < 64; ++pp) { const float2 pv = pw[(dg * 64 + pp) * 17 + d]; const float cr = p.c_re[(dg * 16 + hp) * 64 + pp], ci = p.c_im[(dg * 16 + hp) * 64 + pp];
      const float2 bb = bbar[(dg * 64 + pp) * 16 + h]; const float xr = cr * pv.x - ci * pv.y, xi = cr * pv.y + ci * pv.x; s += xr * bb.x - xi * bb.y; }
    Kt[i] = s; }
  for (size_t i8 = gid; i8 < (size_t)32 * 256 * 256 / 8; i8 += gsz) { const size_t i = i8 * 8; const int k = i & 255, n = (i >> 8) & 255, g = i >> 16; const int s = k >> 4, h = k & 15, dirS = n >> 7, pp = (n >> 1) & 63, ri = n & 1;
    const int dg = dirS * 32 + g, e = dirS ? s : 15 - s; const float2 pv = pw[(dg * 64 + pp) * 17 + e]; const float2* bb = bbar + (dg * 64 + pp) * 16 + h; float v[8];
#pragma unroll
    for (int q = 0; q < 8; ++q) { const float2 b_ = bb[q]; v[q] = ri ? (pv.x * b_.y + pv.y * b_.x) : (pv.x * b_.x - pv.y * b_.y); }
    u32x4 w = {cvtpk(v[0], v[1]), cvtpk(v[2], v[3]), cvtpk(v[4], v[5]), cvtpk(v[6], v[7])}; *(u32x4*)(WS + i) = w; }
}
__device__ __forceinline__ void build_tables_p2(const P& p) {
  const size_t gid = blockIdx.x * 512ull + threadIdx.x, gsz = gridDim.x * 512ull;
  const float2* pw = WSP(float2, O_PW); const float* Kt = WSP(float, O_KT); bf16* Msg = WSP(bf16, O_MSG);
  for (size_t i8 = gid; i8 < (size_t)32 * 256 * 512 / 8; i8 += gsz) { const size_t i = i8 * 8; const int k = i & 511, n = (i >> 9) & 255, g = i >> 17; const int t = n >> 4, hp = n & 15; float v[8];
    if (k < 256) { const int s = k >> 4, h = k & 15, o = hp * 16 + h;
      if (s != t) { const float* kt = (s < t) ? Kt + ((size_t)g * 16 + (t - s)) * 256 + o : Kt + ((size_t)(32 + g) * 16 + (s - t)) * 256 + o;
        const f32x4v a = *(const f32x4v*)kt, b = *(const f32x4v*)(kt + 4);
        v[0] = a[0]; v[1] = a[1]; v[2] = a[2]; v[3] = a[3]; v[4] = b[0]; v[5] = b[1]; v[6] = b[2]; v[7] = b[3]; }
      else { const float* k0 = Kt + ((size_t)g * 16) * 256 + o; const float* k1 = Kt + ((size_t)(32 + g) * 16) * 256 + o;
        const f32x4v a = *(const f32x4v*)k0, b = *(const f32x4v*)(k0 + 4), c = *(const f32x4v*)k1, d = *(const f32x4v*)(k1 + 4);
        v[0] = a[0] + c[0]; v[1] = a[1] + c[1]; v[2] = a[2] + c[2]; v[3] = a[3] + c[3]; v[4] = b[0] + d[0]; v[5] = b[1] + d[1]; v[6] = b[2] + d[2]; v[7] = b[3] + d[3]; }
    } else { const int kk = k - 256, dirX = kk >> 7, pp0 = (kk >> 1) & 63, dg = dirX * 32 + g, e = dirX ? 16 - t : t + 1;
#pragma unroll
      for (int q = 0; q < 4; ++q) { const int pp = pp0 + q; const float2 pv = pw[(dg * 64 + pp) * 17 + e]; const float cr = p.c_re[(dg * 16 + hp) * 64 + pp], ci = p.c_im[(dg * 16 + hp) * 64 + pp];
        v[2 * q] = cr * pv.x - ci * pv.y; v[2 * q + 1] = -(cr * pv.y + ci * pv.x); } }
    u32x4 w = {cvtpk(v[0], v[1]), cvtpk(v[2], v[3]), cvtpk(v[4], v[5]), cvtpk(v[6], v[7])}; *(u32x4*)(Msg + i) = w; }
}
constexpr int NT_SSMS = 256, NT_SSMY = 512;
__device__ __forceinline__ void phase_ssmS(const P& p, int tile, char* lds) {
  const int g = tile >> 3, mt = tile & 7, m0 = mt * 256;
  f32x16 acc[4][2]; ALBn al{WSP(bf16, O_SUG) + (size_t)g * RP * GH, 256, 2047};
  gemm_main<256, 256, 64, 2, 4, -1>(lds, al, m0, WSP(bf16, O_WS) + (size_t)g * 65536, 256, 0, 255, 256, acc);
  const int tid_ = otid(), lane = tid_ & 63, wid = tid_ >> 6, wm = wid >> 2, wn = wid & 3, r32 = lane & 31, hi = lane >> 5;
  float* S = WSP(float, O_S) + (size_t)g * 2048 * 256;
#pragma unroll
  for (int i = 0; i < 4; ++i)
#pragma unroll
    for (int j = 0; j < 2; ++j)
#pragma unroll
      for (int q = 0; q < 4; ++q) { f32x4v t4 = {acc[i][j][4 * q], acc[i][j][4 * q + 1], acc[i][j][4 * q + 2], acc[i][j][4 * q + 3]};
        *(f32x4v*)(S + (size_t)(m0 + wm * 128 + i * 32 + r32) * 256 + wn * 64 + j * 32 + 8 * q + 4 * hi) = t4; }
  __syncthreads();
}
struct ALU3 { const bf16* u; const bf16* xa; using Raw = u32x4;
  __device__ __forceinline__ Raw load(int m, int k) const { return *(const u32x4*)(k < 256 ? u + (size_t)m * 256 + k : xa + (size_t)m * 256 + (k - 256)); }
  __device__ __forceinline__ bf16x8 cvt(const Raw& v, int k, float& ss) const { return (bf16x8)v; } };
__device__ __forceinline__ void phase_ssmY(const P& p, int tile, char* lds) {
  const int g = tile >> 4, mt = (tile >> 1) & 7, nt = tile & 1, m0 = mt * 256, n0 = nt * 128;
  const bf16* ug = WSP(bf16, O_SUG) + (size_t)g * RP * GH;
  f32x16 acc[2][2]; ALU3 al{ug, WSP(bf16, O_XA) + (size_t)g * 2048 * 256};
  gemm_main<256, 128, 64, 4, 2, -1>(lds, al, m0, WSP(bf16, O_MSG) + (size_t)g * 256 * 512, 512, n0, 255, 512, acc);
  const int tid_ = otid(), lane = tid_ & 63, wid = tid_ >> 6, wm = wid >> 1, wn = wid & 1, r32 = lane & 31, hi = lane >> 5;
  bf16* ysg = WSP(bf16, O_YSG);
#pragma unroll
  for (int i = 0; i < 2; ++i)
#pragma unroll
    for (int j = 0; j < 2; ++j) { const int m = m0 + wm * 64 + i * 32 + r32;
#pragma unroll
      for (int q = 0; q < 4; ++q) { const int n = n0 + wn * 64 + j * 32 + 8 * q + 4 * hi, t = n >> 4, hp = n & 15;
        const f32x4v dd = *(const f32x4v*)(p.ssm_d + g * 16 + hp); const uint2 uw = *(const uint2*)(ug + (size_t)m * 256 + n);
        const float y0 = acc[i][j][4 * q] + dd[0] * bflo(uw.x), y1 = acc[i][j][4 * q + 1] + dd[1] * bfhi(uw.x), y2 = acc[i][j][4 * q + 2] + dd[2] * bflo(uw.y), y3 = acc[i][j][4 * q + 3] + dd[3] * bfhi(uw.y);
        *(uint2*)(ysg + ((size_t)m * 16 + t) * DS + g * 16 + hp) = pack4(gelu_tanh(y0), gelu_tanh(y1), gelu_tanh(y2), gelu_tanh(y3)); } }
  __syncthreads();
}
__device__ __forceinline__ float2 cmul(float2 a, float2 b) { return make_float2(a.x * b.x - a.y * b.y, a.x * b.y + a.y * b.x); }
__device__ __forceinline__ float2 cfma(float2 a, float2 x, float2 s) { return make_float2(a.x * x.x - a.y * x.y + s.x, a.x * x.y + a.y * x.x + s.y); }
__device__ __forceinline__ void phase_carry1(const P& p) {
  const int nthr = 2 * 32 * 2 * 32 * 64; const float2* pw = WSP(float2, O_PW); float2* E = WSP(float2, O_E);
  for (int idx = blockIdx.x * 512 + threadIdx.x; idx < nthr; idx += gridDim.x * 512) {
    const int pp = idx & 63, sc = (idx >> 6) & 31, dir = (idx >> 11) & 1, g = (idx >> 12) & 31, b = idx >> 17;
    const float2 a16 = pw[((dir * 32 + g) * 64 + pp) * 17 + 16];
    const float* S = WSP(float, O_S) + ((size_t)g * 2048 + b * 1024) * 256 + dir * 128 + pp * 2; float2 X = make_float2(0.f, 0.f);
    for (int q = 0; q < 32; ++q) { const int c = sc * 32 + (dir ? 31 - q : q); const float2 s = *(const float2*)(S + (size_t)c * 256); X = cfma(a16, X, s); }
    E[idx] = X; }
}
__device__ __forceinline__ void phase_carry2(const P& p) {
  const int nthr = 2 * 32 * 2 * 32 * 64; const float2* pw = WSP(float2, O_PW); const float2* E = WSP(float2, O_E); const float2* bbar = WSP(float2, O_BBAR);
  for (int idx = blockIdx.x * 512 + threadIdx.x; idx < nthr; idx += gridDim.x * 512) {
    const int pp = idx & 63, sc = (idx >> 6) & 31, dir = (idx >> 11) & 1, g = (idx >> 12) & 31, b = idx >> 17;
    const int dgp = (dir * 32 + g) * 64 + pp; const float2 a16 = pw[dgp * 17 + 16];
    float2 a512 = a16;
#pragma unroll
    for (int q = 0; q < 5; ++q) a512 = cmul(a512, a512);
    float2 X = make_float2(0.f, 0.f); const float2* Eb = E + (idx & ~(31 << 6) & ~63) + pp;
    if (dir == 0) {
      const bf16* um = WSP(bf16, O_SUG) + ((size_t)g * RP + RX) * GH;
      for (int s = 0; s < 16; ++s) { float2 bu = make_float2(0.f, 0.f);
        for (int h = 0; h < 16; ++h) { const float u = bf2f(um[s * 16 + h]); const float2 bb = bbar[dgp * 16 + h]; bu.x += bb.x * u; bu.y += bb.y * u; }
        X = cfma(pw[dgp * 17 + 1], X, bu); }
      for (int j = 0; j < sc; ++j) X = cfma(a512, X, Eb[j * 64]);
    } else {
      for (int j = 31; j > sc; --j) X = cfma(a512, X, Eb[j * 64]);
    }
    const float* S = WSP(float, O_S) + ((size_t)g * 2048 + b * 1024) * 256 + dir * 128 + pp * 2;
    bf16* XA = WSP(bf16, O_XA) + ((size_t)g * 2048 + b * 1024) * 256 + dir * 128 + pp * 2;
    for (int q = 0; q < 32; ++q) { const int c = sc * 32 + (dir ? 31 - q : q);
      *(unsigned*)(XA + (size_t)c * 256) = cvtpk(X.x, X.y);
      const float2 s = *(const float2*)(S + (size_t)c * 256); X = cfma(a16, X, s); }
  }
}


#define XB_TMO      128
#define XB_XCNT(j)  (256  + 64 * (j))
#define XB_XSUB(j)  (1280 + 64 * (j))
#define XB_XGEN(j)  (2304 + 64 * (j))
#define XB_TOP      3328
#define XB_TOPGEN   3392
#define XCD_BAR_WORDS 3456
#define XB_SPIN_CAP (1u << 22)
#define LAS __attribute__((address_space(3)))
__device__ __forceinline__ unsigned xb_ld(unsigned* p)              { return __hip_atomic_load(p, __ATOMIC_RELAXED, __HIP_MEMORY_SCOPE_AGENT); }
__device__ __forceinline__ unsigned xb_add(unsigned* p, unsigned v) { return __hip_atomic_fetch_add(p, v, __ATOMIC_RELAXED, __HIP_MEMORY_SCOPE_AGENT); }
__device__ __forceinline__ unsigned xb_xcc_id() { return (unsigned)__builtin_amdgcn_s_getreg((3 << 11) | 20) & 0xFu; }
#define XB_SPIN(cond, bar) do { unsigned _sp = 0; while (cond) { __builtin_amdgcn_s_sleep(1); \
    if ((++_sp & 255u) == 0u) { if (xb_ld(&(bar)[XB_TMO])) break; if (_sp > XB_SPIN_CAP) { atomicAdd(&(bar)[XB_TMO], 1u); break; } } } } while (0)
struct XcdBarrier { unsigned* bar; unsigned x; volatile LAS unsigned* st; };
__device__ __forceinline__ XcdBarrier xcd_barrier_post(unsigned* bar, volatile LAS unsigned* st) {
  XcdBarrier b; b.bar = bar; b.x = xb_xcc_id(); b.st = st;
  if (threadIdx.x == 0) (void)xb_add(&bar[XB_XCNT(b.x)], 1u);
  return b;
}
__device__ __forceinline__ void xcd_barrier_complete(unsigned* bar, unsigned x, unsigned& nloc, unsigned& nx) {
  const unsigned G = gridDim.x * gridDim.y * gridDim.z; unsigned sum, cnt, mine, sp = 0u;
  for (;;) {
    sum = 0u; cnt = 0u; mine = 0u;
#pragma unroll
    for (unsigned j = 0; j < 16; ++j) { const unsigned c = xb_ld(&bar[XB_XCNT(j)]); sum += c; cnt += (c > 0u) ? 1u : 0u; mine = (j == x) ? c : mine; }
    if (sum == G) break;
    __builtin_amdgcn_s_sleep(1);
    if ((++sp & 255u) == 0u) { if (xb_ld(&bar[XB_TMO])) break; if (sp > XB_SPIN_CAP) { atomicAdd(&bar[XB_TMO], 1u); break; } }
  }
  nloc = mine > 0u ? mine : 1u; nx = cnt > 0u ? cnt : 1u;
}
__device__ __forceinline__ void xcd_barrier(const XcdBarrier& b) {
  asm volatile("s_waitcnt vmcnt(0)" ::: "memory");
  __syncthreads();
  if (threadIdx.x == 0) {
    unsigned* bar = b.bar;
    __builtin_amdgcn_s_waitcnt(0);
    unsigned nloc = b.st[0], nx = b.st[1];
    if (nloc == 0u) { xcd_barrier_complete(bar, b.x, nloc, nx); b.st[0] = nloc; b.st[1] = nx; }
    const unsigned old = xb_add(&bar[XB_XSUB(b.x)], 1u);
    const unsigned gen = old / nloc;
    if (old + 1u == (gen + 1u) * nloc) {
      __builtin_amdgcn_fence(__ATOMIC_RELEASE, "agent");
      asm volatile("s_waitcnt vmcnt(0)" ::: "memory");
      const unsigned og = xb_add(&bar[XB_TOP], 1u);
      const unsigned tg = og / nx;
      if (og + 1u == (tg + 1u) * nx) xb_add(&bar[XB_TOPGEN], 1u);
      else XB_SPIN(xb_ld(&bar[XB_TOPGEN]) == tg, bar);
      __builtin_amdgcn_fence(__ATOMIC_ACQUIRE, "agent");
      xb_add(&bar[XB_XGEN(b.x)], 1u);
      asm volatile("s_waitcnt vmcnt(0)" ::: "memory");
    } else {
      XB_SPIN(xb_ld(&bar[XB_XGEN(b.x)]) == gen, bar);
      __builtin_amdgcn_fence(__ATOMIC_ACQUIRE, "agent");
      asm volatile("s_waitcnt vmcnt(0)" ::: "memory");
    }
  }
  __syncthreads();
}

__global__ void __launch_bounds__(512) k_mega(P p) {
  __shared__ __attribute__((aligned(16))) char lds[LDS_BYTES];
  cg::grid_group grid = cg::this_grid();
  __shared__ uint4 xb_words;
  if (threadIdx.x == 0) xb_words = make_uint4(0u, 0u, 0u, 0u);
  __syncthreads();
  XcdBarrier xbar = xcd_barrier_post(WSP(unsigned, O_BAR), (volatile LAS unsigned*)&xb_words);
#define GSYNC() do { for (int q_ = 0; q_ < REP_SYNC; ++q_) xcd_barrier(xbar); } while (0)
  prep_all(p, lds);
  grid.sync();
  build_tables_p1(p);
  for (int rep = 0; rep < REP_INPROJ; ++rep) for (int t = blockIdx.x; t < NT_INPROJ; t += gridDim.x) phase_inproj(p, t, lds);
  GSYNC();
  build_tables_p2(p);
  for (int rep = 0; rep < REP_P2; ++rep)
  for (int t = blockIdx.x; t < NT_QUP + NT_KVUP + NT_SSMS; t += gridDim.x) { if (t < NT_QUP) phase_qup(p, t, lds); else if (t < NT_QUP + NT_KVUP) phase_kvup(p, t - NT_QUP, lds); else phase_ssmS(p, t - NT_QUP - NT_KVUP, lds); }
  GSYNC();
  phase_carry1(p);
  GSYNC();
  phase_carry2(p);
  GSYNC();
  for (int rep = 0; rep < REP_ATTN; ++rep)
  for (int t = blockIdx.x; t < NT_ATTN + NT_SSMY; t += gridDim.x) { if (t < NT_ATTN) attn_item<true>(p, t, lds); else phase_ssmY(p, t - NT_ATTN, lds); }
  GSYNC();
  for (int rep = 0; rep < REP_GLU; ++rep) for (int t = blockIdx.x; t < NT_GLU; t += gridDim.x) phase_glu(p, t, lds);
  GSYNC();
  for (int rep = 0; rep < REP_OUT; ++rep) for (int t = blockIdx.x; t < NT_OUT; t += gridDim.x) phase_out(p, t, lds);
  GSYNC();
  for (int rep = 0; rep < REP_FIN; ++rep) phase_final(p);
}

extern "C" void kernel_launch(void* const* d_in, const int* in_sizes, int n_in, void* d_out, int out_size, void* d_ws, size_t ws_size, hipStream_t stream) {
  P p{};
  const float** f = (const float**)&p;
  for (int i = 0; i < 22; ++i) f[i] = (const float*)d_in[i];
  p.out = (float*)d_out; p.ws = (char*)d_ws;
  if (ws_size < O_END) { fprintf(stderr, "ws too small\n"); return; }
  static int grid_blocks = 0;
  if (!grid_blocks) {
    int dev = 0, cus = 0, per_cu = 0; hipGetDevice(&dev);
    hipDeviceGetAttribute(&cus, hipDeviceAttributeMultiprocessorCount, dev);
    hipOccupancyMaxActiveBlocksPerMultiprocessor(&per_cu, k_mega, 512, 0);
    if (per_cu < 1) per_cu = 1;
    grid_blocks = cus * per_cu;
  }
  hipMemsetAsync((char*)d_ws + O_BAR, 0, 4096 * 4, stream);
  void* args[] = {&p};
  hipError_t e = hipLaunchCooperativeKernel((void*)k_mega, dim3(grid_blocks), dim3(512), args, 0, stream);
  if (e != hipSuccess) fprintf(stderr, "cooperative launch failed: %s (grid %d)\n", hipGetErrorString(e), grid_blocks);
}
```

```cpp
#include <hip/hip_runtime.h>
#include <hip/hip_bf16.h>
#include <hip/hip_cooperative_groups.h>
#include <cstdio>
namespace cg = cooperative_groups;
#include <stdint.h>
typedef __hip_bfloat16 bf16;
#ifndef REP_ATTN
#define REP_ATTN 1
#endif
#ifndef REP_INPROJ
#define REP_INPROJ 1
#endif
#ifndef REP_TAIL
#define REP_TAIL 1
#endif
#ifndef REP_P2
#define REP_P2 1
#endif
#ifndef REP_GLU
#define REP_GLU 1
#endif
#ifndef REP_OUT
#define REP_OUT 1
#endif
#ifndef REP_FIN
#define REP_FIN 1
#endif
#ifndef REP_SYNC
#define REP_SYNC 1
#endif

constexpr int DM = 1024, SEQ = 16384, NB = 2, NMETA = 16, LTOT = SEQ + NMETA;
constexpr int DIN = 1952, QL = 256, KVL = 128, QR = 32, DA = 512, DS = 512;
constexpr int NH = 8, DQK = 96, DV = 64, NG = 32, GH = 16, NP = 64;
constexpr int RX = NB * SEQ;
constexpr int RT = RX + NMETA;
constexpr int RP = 33024;
constexpr int KPAD = 48;
constexpr int NKEY = LTOT + KPAD;
constexpr float EPS = 1e-6f;
constexpr int LDK = DM + 64;

constexpr size_t al(size_t x) { return (x + 255) / 256 * 256; }
constexpr size_t O_WTIN = 0;
constexpr size_t O_WTQ = O_WTIN + al((size_t)DIN * LDK * 2);
constexpr size_t O_WTKV = O_WTQ + al((size_t)768 * QL * 2);
constexpr size_t O_WTGLU = O_WTKV + al((size_t)1024 * KVL * 2);
constexpr size_t O_WTOUT = O_WTGLU + al((size_t)1024 * DS * 2);
constexpr size_t O_BGLU = O_WTOUT + al((size_t)DM * DM * 2);
constexpr size_t O_ROPE = O_BGLU + al(1024 * 4);
constexpr size_t O_ABAR = O_ROPE + al((size_t)LTOT * 16 * 8);
constexpr size_t O_BBAR = O_ABAR + al(2 * 32 * 64 * 8);
constexpr size_t O_QLAT = O_BBAR + al(2 * 32 * 64 * 16 * 8);
constexpr size_t O_KVLAT = O_QLAT + al((size_t)RP * QL * 2);
constexpr size_t O_AGATE = O_KVLAT + al((size_t)RP * KVL * 2);
constexpr size_t O_SGATE = O_AGATE + al((size_t)RX * DA * 2);
constexpr size_t O_SUG = O_SGATE + al((size_t)RX * DS * 2);
constexpr size_t O_KN = O_SUG + al((size_t)NG * RP * GH * 2);
constexpr size_t O_V = O_KN + al((size_t)NB * NH * NKEY * 64 * 2);
constexpr size_t O_KR = O_V + al((size_t)NB * NH * NKEY * 64 * 2);
constexpr size_t O_Q = O_KR + al((size_t)NB * NKEY * 32 * 2);
constexpr size_t O_YA = O_Q + al((size_t)NB * NH * SEQ * DQK * 2);
constexpr size_t O_YSG = O_YA + al((size_t)RX * DA * 2);
constexpr size_t O_YSN = O_YSG + al((size_t)RX * DS * 2);
constexpr size_t O_RSX = O_YSN + al((size_t)RX * DS * 2);
constexpr size_t O_RSQ = O_RSX + al(RP * 4);
constexpr size_t O_RSKV = O_RSQ + al(RP * 4);
constexpr size_t O_RSA = O_RSKV + al(RP * 4);
constexpr size_t O_PW = O_RSA + al(RP * 4);
constexpr size_t O_KT = O_PW + al(2 * 32 * 64 * 17 * 8);
constexpr size_t O_WS = O_KT + al(2 * 32 * 16 * 256 * 4);
constexpr size_t O_MSG = O_WS + al((size_t)32 * 256 * 256 * 2);
constexpr size_t O_S = O_MSG + al((size_t)32 * 256 * 512 * 2);
constexpr size_t O_XB = O_S;
constexpr size_t O_E = O_S + al((size_t)RP * LDK * 2);
constexpr size_t O_XA = O_E + al((size_t)2 * 32 * 2 * 32 * 64 * 8);
constexpr size_t O_BAR = O_XA + al((size_t)32 * 2048 * 256 * 2);
constexpr size_t O_GPART = O_BAR + al(4096 * 4);
constexpr size_t O_YPART = O_GPART + al((size_t)16 * RX * 4);
constexpr size_t O_Y = O_S;
constexpr size_t O_END = O_YPART + al((size_t)16 * RX * 4);

struct P {
  const float *x, *meta, *pre_w, *post_w, *w_in, *qn_w, *w_qup, *kvn_w, *w_kvup, *aon_w;
  const float *a_re, *a_im, *log_dt, *b_re, *b_im, *c_re, *c_im, *ssm_d, *w_glu, *b_glu, *son_w, *w_out;
  float* out; char* ws;
};
#define WSP(T, off) ((T*)(p.ws + (off)))

__device__ __forceinline__ float bf2f(bf16 v) { return __bfloat162float(v); }
__device__ __forceinline__ bf16 f2bf(float v) { return __float2bfloat16(v); }
__device__ __forceinline__ float silu(float v) { return v / (1.f + __expf(-v)); }
__device__ __forceinline__ float gelu_tanh(float v) {
  const float u = 0.7978845608028654f * (v + 0.044715f * v * v * v);
  return v / (1.f + __expf(-2.f * u));
}
__device__ __forceinline__ const float* xrow(const P& p, int r) {
  return r < RX ? p.x + (size_t)r * DM : p.meta + (size_t)(r - RX) * DM;
}
__device__ __forceinline__ void sincos_red(double ang, float& c, float& s) {
  const double TWO_PI = 6.283185307179586476925;
  double n = rint(ang / TWO_PI); float r = (float)(ang - n * TWO_PI);
  c = cosf(r); s = sinf(r);
}

using bf16x8 = __attribute__((ext_vector_type(8))) short;
using f32x16 = __attribute__((ext_vector_type(16))) float;
using f32x4v = __attribute__((ext_vector_type(4))) float;
using u32x4 = __attribute__((ext_vector_type(4))) unsigned;
__device__ __forceinline__ int otid() { int t = threadIdx.x; asm volatile("" : "+v"(t)); return t; }
__device__ __forceinline__ int crow(int r, int hi) { return (r & 3) + 8 * (r >> 2) + 4 * hi; }
__device__ __forceinline__ unsigned cvtpk(float lo, float hi) { unsigned r; asm("v_cvt_pk_bf16_f32 %0, %1, %2" : "=v"(r) : "v"(lo), "v"(hi)); return r; }
__device__ __forceinline__ float bflo(unsigned u) { return __uint_as_float(u << 16); }
__device__ __forceinline__ float bfhi(unsigned u) { return __uint_as_float(u & 0xffff0000u); }
__device__ __forceinline__ void stbf(bf16* dst, float v) { *(unsigned short*)dst = (unsigned short)(cvtpk(v, v) & 0xffffu); }

__device__ __forceinline__ void prep_transposes(const P& p, char* lds) {
  float* T = (float*)lds; const int tid = threadIdx.x;
  constexpr int T_IN = 16 * 31, T_OUT = 16 * 16, T_GLU = 8 * 16, T_Q = 4 * 12, T_KV = 2 * 16, T_ALL = T_IN + T_OUT + T_GLU + T_Q + T_KV;
  for (int t = blockIdx.x; t < T_ALL; t += gridDim.x) {
    const float* W; const float* g0; const float* g1 = nullptr; bf16* dst; int N, ldk, kt, nt_, which;
    if (t < T_IN) { which = 0; W = p.w_in; g0 = p.pre_w; dst = WSP(bf16, O_WTIN); N = DIN; ldk = LDK; kt = t / 31; nt_ = t % 31; }
    else if (t < T_IN + T_OUT) { const int u = t - T_IN; which = 1; W = p.w_out; g0 = p.aon_w; g1 = p.son_w; dst = WSP(bf16, O_WTOUT); N = DM; ldk = DM; kt = u >> 4; nt_ = u & 15; }
    else if (t < T_IN + T_OUT + T_GLU) { const int u = t - T_IN - T_OUT; which = 2; W = p.w_glu; g0 = nullptr; dst = WSP(bf16, O_WTGLU); N = 1024; ldk = DS; kt = u >> 4; nt_ = u & 15; }
    else if (t < T_IN + T_OUT + T_GLU + T_Q) { const int u = t - T_IN - T_OUT - T_GLU; which = 3; W = p.w_qup; g0 = p.qn_w; dst = WSP(bf16, O_WTQ); N = 768; ldk = QL; kt = u / 12; nt_ = u % 12; }
    else { const int u = t - T_IN - T_OUT - T_GLU - T_Q; which = 4; W = p.w_kvup; g0 = p.kvn_w; dst = WSP(bf16, O_WTKV); N = 1024; ldk = KVL; kt = u >> 4; nt_ = u & 15; }
    const int k0 = kt * 64, n0 = nt_ * 64;
#pragma unroll
    for (int i = 0; i < 8; ++i) { const int kk = (tid >> 6) + 8 * i, nn = tid & 63, k = k0 + kk, n = n0 + nn;
      float gk = 1.f; if (which == 1) gk = k < 512 ? g0[k] : g1[k - 512]; else if (g0) gk = g0[k];
      T[kk * 65 + nn] = (n < N) ? W[(size_t)k * N + n] * gk : 0.f; }
    __syncthreads();
    { const int nn = tid >> 3, kc = tid & 7, n = n0 + nn;
      if (n < N) { int row = n; if (which == 2) row = n < 512 ? ((n >> 5) * 64 + (n & 31)) : (((n - 512) >> 5) * 64 + 32 + (n & 31));
        float v[8];
#pragma unroll
        for (int e = 0; e < 8; ++e) v[e] = T[(kc * 8 + e) * 65 + nn];
        u32x4 w = {cvtpk(v[0], v[1]), cvtpk(v[2], v[3]), cvtpk(v[4], v[5]), cvtpk(v[6], v[7])};
        *(u32x4*)(dst + (size_t)row * ldk + k0 + kc * 8) = w; } }
    __syncthreads();
  }
}
__device__ __forceinline__ void prep_all(const P& p, char* lds) {
  const size_t gid = blockIdx.x * (size_t)blockDim.x + threadIdx.x, gsz = gridDim.x * (size_t)blockDim.x;
  prep_transposes(p, lds);
  { float* bglu = WSP(float, O_BGLU);
    for (size_t i = gid; i < 1024; i += gsz) { const int sc = (int)i; const int n = sc < 512 ? ((sc >> 5) * 64 + (sc & 31)) : (((sc - 512) >> 5) * 64 + 32 + (sc & 31)); bglu[n] = p.b_glu[sc]; } }
  { const int lane = threadIdx.x & 63; bf16* xb = WSP(bf16, O_XB); float* rsx = WSP(float, O_RSX);
    for (size_t row = gid >> 6; row < (size_t)RT; row += gsz >> 6) { const float* xr = xrow(p, (int)row); float ss = 0.f;
#pragma unroll
      for (int q = 0; q < 4; ++q) { const f32x4v v = *(const f32x4v*)(xr + q * 256 + lane * 4); ss += v[0] * v[0] + v[1] * v[1] + v[2] * v[2] + v[3] * v[3];
        uint2 w; w.x = cvtpk(v[0], v[1]); w.y = cvtpk(v[2], v[3]); *(uint2*)(xb + row * LDK + q * 256 + lane * 4) = w; }
#pragma unroll
      for (int o = 32; o > 0; o >>= 1) ss += __shfl_xor(ss, o);
      if (lane == 0) rsx[row] = rsqrtf(ss * (1.f / DM) + EPS); } }
  float2* rope = WSP(float2, O_ROPE);
  for (size_t i = gid; i < (size_t)LTOT * 16; i += gsz) {
    int pos = i / 16, j = i % 16; float inv = powf(10000.f, -(float)j / 16.f); float ang = (float)pos * inv;
    float c, s; sincos_red((double)ang, c, s); rope[i] = make_float2(c, s); }
  float2* abar = WSP(float2, O_ABAR); float2* bbar = WSP(float2, O_BBAR);
  for (size_t i = gid; i < 2 * 32 * 64; i += gsz) {
    int dg = i / 64; double dt = exp((double)p.log_dt[dg]); double are = p.a_re[i], aim = p.a_im[i];
    double mag = exp(are * dt); float c, s; sincos_red(aim * dt, c, s);
    double br = mag * (double)c, bi = mag * (double)s;
    br = mag * cos(aim * dt); bi = mag * sin(aim * dt);
    abar[i] = make_float2((float)br, (float)bi);
    { float2* pw = WSP(float2, O_PW) + i * 17;
      double pr = 1.0, pi_ = 0.0;
      for (int d = 0; d <= 16; ++d) { pw[d] = make_float2((float)pr, (float)pi_); const double nr_ = pr * br - pi_ * bi, ni_ = pr * bi + pi_ * br; pr = nr_; pi_ = ni_; } }
    double nr = br - 1.0, ni = bi, den = are * are + aim * aim;
    double cr = (nr * are + ni * aim) / den, ci = (ni * are - nr * aim) / den;
    for (int h = 0; h < 16; ++h) { double b_r = p.b_re[i * 16 + h], b_i = p.b_im[i * 16 + h];
      bbar[i * 16 + h] = make_float2((float)(cr * b_r - ci * b_i), (float)(cr * b_i + ci * b_r)); }
  }
  bf16* kn = WSP(bf16, O_KN); bf16* vv = WSP(bf16, O_V); bf16* kr = WSP(bf16, O_KR);
  for (size_t i = gid; i < (size_t)NB * NH * KPAD * 64; i += gsz) { size_t bh = i / (KPAD * 64), rem = i % (KPAD * 64); kn[bh * NKEY * 64 + rem] = f2bf(0.f); vv[bh * NKEY * 64 + rem] = f2bf(0.f); }
  for (size_t i = gid; i < (size_t)NB * KPAD * 32; i += gsz) { size_t b = i / (KPAD * 32), rem = i % (KPAD * 32); kr[b * NKEY * 32 + rem] = f2bf(0.f); }
}

template <int RB> __device__ __forceinline__ int swz(int row, int chunk) { return row * RB + ((chunk ^ ((row / (256 / RB)) & (RB / 16 - 1))) << 4); }

constexpr int LDS_ROWSS = 131072;
constexpr int LDS_RED = LDS_ROWSS + 1024;
constexpr int LDS_BYTES = LDS_RED + 2048;

struct ALX {
  const float* x; const float* meta;
  struct Raw { f32x4v a, b; };
  __device__ __forceinline__ Raw load(int m, int k) const { m = m < RT ? m : RT - 1;
    const float* r = (m < RX ? x + (size_t)m * DM : meta + (size_t)(m - RX) * DM) + k; Raw v; v.a = *(const f32x4v*)r; v.b = *(const f32x4v*)(r + 4); return v; }
  __device__ __forceinline__ bf16x8 cvt(const Raw& v, int k, float& ss) const {
    ss += v.a[0] * v.a[0] + v.a[1] * v.a[1] + v.a[2] * v.a[2] + v.a[3] * v.a[3] + v.b[0] * v.b[0] + v.b[1] * v.b[1] + v.b[2] * v.b[2] + v.b[3] * v.b[3];
    u32x4 w = {cvtpk(v.a[0], v.a[1]), cvtpk(v.a[2], v.a[3]), cvtpk(v.b[0], v.b[1]), cvtpk(v.b[2], v.b[3])}; return (bf16x8)w; }
};
__device__ __forceinline__ float ss8(u32x4 v) { float s = 0.f;
#pragma unroll
  for (int j = 0; j < 4; ++j) { float a = bflo(v[j]), b = bfhi(v[j]); s += a * a + b * b; } return s; }
struct ALB {
  const bf16* a; int ld; int mmax; using Raw = u32x4;
  __device__ __forceinline__ Raw load(int m, int k) const { m = m < mmax ? m : mmax; return *(const u32x4*)(a + (size_t)m * ld + k); }
  __device__ __forceinline__ bf16x8 cvt(const Raw& v, int k, float& ss) const { ss += ss8(v); return (bf16x8)v; }
};
struct ALBn {
  const bf16* a; int ld; int mmax; using Raw = u32x4;
  __device__ __forceinline__ Raw load(int m, int k) const { m = m < mmax ? m : mmax; return *(const u32x4*)(a + (size_t)m * ld + k); }
  __device__ __forceinline__ bf16x8 cvt(const Raw& v, int k, float& ss) const { return (bf16x8)v; }
};
struct ALOut {
  const bf16* ya; const bf16* ysn; using Raw = u32x4;
  __device__ __forceinline__ Raw load(int m, int k) const { return *(const u32x4*)(k < 512 ? ya + (size_t)m * 512 + k : ysn + (size_t)m * 512 + (k - 512)); }
  __device__ __forceinline__ bf16x8 cvt(const Raw& v, int k, float& ss) const { if (k < 512) ss += ss8(v); return (bf16x8)v; }
};

template <int BM, int BN, int BK, int WGM, int WGN, int MIDKT, class AL>
__device__ __forceinline__ void gemm_main(char* lds, const AL& al, int m0, const bf16* __restrict__ Bt, int ldb, int n0, int nmax, int K,
                                          f32x16 (&acc)[BM / WGM / 32][BN / WGN / 32], const float* midsc = nullptr) {
  constexpr int CPR = BK / 8, RB = BK * 2, RPS = 512 / CPR, A_CH = (BM + RPS - 1) / RPS, B_CH = BN / RPS;
  constexpr int TM = BM / WGM / 32, TN = BN / WGN / 32, A_BYTES = BM * RB, STAGE = (BM + BN) * RB;
  const int tid = otid(), lane = tid & 63, wid = tid >> 6, wm = wid / WGN, wn = wid % WGN, r32 = lane & 31, hi = lane >> 5;
  const int srow = tid / CPR, sch = tid % CPR;
  float* rowss = (float*)(lds + LDS_ROWSS);
  typename AL::Raw ra[A_CH]; u32x4 rb[B_CH]; float ss[A_CH];
#pragma unroll
  for (int i = 0; i < A_CH; ++i) ss[i] = 0.f;
#pragma unroll
  for (int i = 0; i < TM; ++i)
#pragma unroll
    for (int j = 0; j < TN; ++j)
#pragma unroll
      for (int r = 0; r < 16; ++r) acc[i][j][r] = 0.f;
#define GLOAD(kt) do { const int k_ = (kt) * BK + sch * 8; \
    _Pragma("unroll") for (int i = 0; i < A_CH; ++i) if (BM % RPS == 0 || srow + i * RPS < BM) ra[i] = al.load(m0 + srow + i * RPS, k_); \
    _Pragma("unroll") for (int i = 0; i < B_CH; ++i) { int n_ = n0 + srow + i * RPS; n_ = n_ < nmax ? n_ : nmax; rb[i] = *(const u32x4*)(Bt + (size_t)n_ * ldb + k_); } } while (0)
#define SWRITE(buf, kt) do { char* base_ = lds + (buf) * STAGE; const int k_ = (kt) * BK + sch * 8; \
    _Pragma("unroll") for (int i = 0; i < A_CH; ++i) if (BM % RPS == 0 || srow + i * RPS < BM) *(bf16x8*)(base_ + swz<RB>(srow + i * RPS, sch)) = al.cvt(ra[i], k_, ss[i]); \
    _Pragma("unroll") for (int i = 0; i < B_CH; ++i) *(u32x4*)(base_ + A_BYTES + swz<RB>(srow + i * RPS, sch)) = rb[i]; } while (0)
#define PUBSS() do { \
    _Pragma("unroll") for (int i = 0; i < A_CH; ++i) { float s_ = ss[i]; \
      _Pragma("unroll") for (int o = 1; o < CPR; o <<= 1) s_ += __shfl_xor(s_, o); \
      if (sch == 0 && (BM % RPS == 0 || srow + i * RPS < BM)) rowss[srow + i * RPS] = s_; } \
    __syncthreads(); } while (0)
  const int nk = K / BK;
  GLOAD(0); SWRITE(0, 0); __syncthreads();
#pragma unroll 1
  for (int kt = 0; kt < nk; ++kt) {
    if (kt + 1 < nk) GLOAD(kt + 1);
    if (MIDKT >= 0 && kt == MIDKT) {
      PUBSS();
#pragma unroll
      for (int i = 0; i < TM; ++i)
      { float rs = rsqrtf(rowss[wm * (TM * 32) + i * 32 + r32] * (1.f / 512.f) + EPS); if (midsc) rs *= midsc[wm * (TM * 32) + i * 32 + r32];
#pragma unroll
        for (int j = 0; j < TN; ++j)
#pragma unroll
          for (int r = 0; r < 16; ++r) acc[i][j][r] *= rs; }
    }
    const char* base = lds + (kt & 1) * STAGE;
#pragma unroll
    for (int ks = 0; ks < BK / 16; ++ks) {
      bf16x8 af[TM], bfr[TN];
#pragma unroll
      for (int i = 0; i < TM; ++i) af[i] = *(const bf16x8*)(base + swz<RB>(wm * (TM * 32) + i * 32 + r32, ks * 2 + hi));
#pragma unroll
      for (int j = 0; j < TN; ++j) bfr[j] = *(const bf16x8*)(base + A_BYTES + swz<RB>(wn * (TN * 32) + j * 32 + r32, ks * 2 + hi));
#pragma unroll
      for (int i = 0; i < TM; ++i)
#pragma unroll
        for (int j = 0; j < TN; ++j) acc[i][j] = __builtin_amdgcn_mfma_f32_32x32x16_bf16(bfr[j], af[i], acc[i][j], 0, 0, 0);
    }
    if (kt + 1 < nk) SWRITE((kt + 1) & 1, kt + 1);
    __syncthreads();
  }
  if (MIDKT < 0) PUBSS();
#undef GLOAD
#undef SWRITE
#undef PUBSS
}

__device__ __forceinline__ int row_pos(int m) { return m < RX ? (m & (SEQ - 1)) + NMETA : m - RX; }
__device__ __forceinline__ uint2 pack4(float a, float b, float c, float d) { uint2 w; w.x = cvtpk(a, b); w.y = cvtpk(c, d); return w; }
__device__ __forceinline__ void rope_block(f32x16& v, const float2* rope_pos, int hi) {
#pragma unroll
  for (int g = 0; g < 2; ++g)
#pragma unroll
    for (int e = 0; e < 4; ++e) { const int r = 4 * g + e; const float2 cs = rope_pos[8 * g + 4 * hi + e];
      const float x1 = v[r], x2 = v[r + 8]; v[r] = x1 * cs.x - x2 * cs.y; v[r + 8] = x1 * cs.y + x2 * cs.x; }
}

constexpr int NT_INPROJ = 5 * 256;
__device__ __forceinline__ void inproj_xform(const P& p, f32x16& a, int m, int nb, int hi, float rs) {
#pragma unroll
  for (int r = 0; r < 16; ++r) a[r] *= rs;
  if (nb == 384) rope_block(a, WSP(float2, O_ROPE) + row_pos(m < RT ? m : RT - 1) * 16, hi);
  else if ((nb >= 416 && nb < 928) || nb >= 1440) {
#pragma unroll
    for (int r = 0; r < 16; ++r) a[r] = silu(a[r]); }
}
constexpr int EP_RS = 144;
__device__ __forceinline__ void inproj_rows(const P& p, char* wl, f32x16& a0, f32x16& a1, int mrow0, int nb0, int lane, int r32, int hi) {
  const int m = mrow0 + r32; const float rs = WSP(float, O_RSX)[m < RT ? m : RT - 1];
  inproj_xform(p, a0, m, nb0, hi, rs); inproj_xform(p, a1, m, nb0 + 32, hi, rs);
#pragma unroll
  for (int g = 0; g < 4; ++g) {
    *(uint2*)(wl + r32 * EP_RS + (8 * g + 4 * hi) * 2) = pack4(a0[4 * g], a0[4 * g + 1], a0[4 * g + 2], a0[4 * g + 3]);
    *(uint2*)(wl + r32 * EP_RS + (32 + 8 * g + 4 * hi) * 2) = pack4(a1[4 * g], a1[4 * g + 1], a1[4 * g + 2], a1[4 * g + 3]); }
#pragma unroll
  for (int it = 0; it < 4; ++it) {
    const int row = it * 8 + (lane >> 3), ch = lane & 7, mm = mrow0 + row, n = nb0 + ch * 8;
    const u32x4 v = *(const u32x4*)(wl + row * EP_RS + ch * 16);
    if (n >= DIN || mm >= RT) continue;
    bf16* dst;
    if (n < 256) dst = WSP(bf16, O_QLAT) + (size_t)mm * QL + n;
    else if (n < 384) dst = WSP(bf16, O_KVLAT) + (size_t)mm * KVL + (n - 256);
    else if (n < 416) { const int pos = row_pos(mm), c = n - 384; bf16* kr = WSP(bf16, O_KR);
      if (mm < RX) dst = kr + ((size_t)(mm >> 14) * NKEY + KPAD + pos) * 32 + c;
      else { *(u32x4*)(kr + ((size_t)NKEY + KPAD + pos) * 32 + c) = v; dst = kr + ((size_t)KPAD + pos) * 32 + c; } }
    else if (n < 928) { if (mm >= RX) continue; dst = WSP(bf16, O_AGATE) + (size_t)mm * DA + (n - 416); }
    else if (n < 1440) { const int c = n - 928; dst = WSP(bf16, O_SUG) + ((size_t)(c >> 4) * RP + mm) * GH + (c & 15); }
    else { if (mm >= RX) continue; dst = WSP(bf16, O_SGATE) + (size_t)mm * DS + (n - 1440); }
    *(u32x4*)dst = v;
  }
}
__device__ __forceinline__ void phase_inproj(const P& p, int tile, char* lds) {
  const int rnd = tile >> 8, s = tile & 255, xcd = s & 7, slot = s >> 3;
  const int mt = rnd * 32 + xcd * 4 + (slot >> 3), nt = slot & 7;
  if (mt > 128) return;
  const int m0 = mt * 256, n0 = nt * 256;
  f32x16 acc[4][2]; ALBn al{WSP(bf16, O_XB), LDK, RT - 1};
  gemm_main<256, 256, 64, 2, 4, -1>(lds, al, m0, WSP(bf16, O_WTIN), LDK, n0, DIN - 1, DM, acc);
  const int tid_ = otid(), lane = tid_ & 63, wid = tid_ >> 6, wm = wid >> 2, wn = wid & 3, r32 = lane & 31, hi = lane >> 5;
  const int mw = m0 + wm * 128, nb = n0 + wn * 64; char* wl = lds + wid * (32 * EP_RS);
  inproj_rows(p, wl, acc[0][0], acc[0][1], mw, nb, lane, r32, hi);
  inproj_rows(p, wl, acc[1][0], acc[1][1], mw + 32, nb, lane, r32, hi);
  inproj_rows(p, wl, acc[2][0], acc[2][1], mw + 64, nb, lane, r32, hi);
  inproj_rows(p, wl, acc[3][0], acc[3][1], mw + 96, nb, lane, r32, hi);
  __syncthreads();
}
constexpr int NT_QUP = (RX / 256) * 3, NT_KVUP = (RP / 256) * 4;
__device__ __forceinline__ void qup_epi(const P& p, f32x16 a, int m, int nb, int hi, float rs) {
  const int h = nb / DQK, c0 = nb % DQK, b = m >> 14, ii = m & (SEQ - 1);
#pragma unroll
  for (int r = 0; r < 16; ++r) a[r] *= rs;
  if (c0 == 64) rope_block(a, WSP(float2, O_ROPE) + (ii + NMETA) * 16, hi);
  bf16* dst = WSP(bf16, O_Q) + (((size_t)b * NH + h) * SEQ + ii) * DQK + c0 + 4 * hi;
#pragma unroll
  for (int g = 0; g < 4; ++g) *(uint2*)(dst + 8 * g) = pack4(a[4 * g], a[4 * g + 1], a[4 * g + 2], a[4 * g + 3]);
}
__device__ __forceinline__ void phase_qup(const P& p, int tile, char* lds) {
  const int mt = tile / 3, nt = tile % 3, m0 = mt * 256, n0 = nt * 256;
  f32x16 acc[4][2]; ALB al{WSP(bf16, O_QLAT), QL, RT - 1};
  gemm_main<256, 256, 64, 2, 4, -1>(lds, al, m0, WSP(bf16, O_WTQ), QL, n0, 767, QL, acc);
  const int tid_ = otid(), lane = tid_ & 63, wid = tid_ >> 6, wm = wid >> 2, wn = wid & 3, r32 = lane & 31, hi = lane >> 5;
  const float* rowss = (const float*)(lds + LDS_ROWSS); const int lr = wm * 128 + r32, nb = n0 + wn * 64;
  constexpr float QC = 0.10206207261596577f * 1.4426950408889634f;
#define QROW(i) do { const float rs_ = rsqrtf(rowss[lr + 32 * (i)] * (1.f / QL) + EPS) * QC; qup_epi(p, acc[i][0], m0 + lr + 32 * (i), nb, hi, rs_); qup_epi(p, acc[i][1], m0 + lr + 32 * (i), nb + 32, hi, rs_); } while (0)
  QROW(0); QROW(1); QROW(2); QROW(3);
#undef QROW
  __syncthreads();
}
__device__ __forceinline__ void kvup_epi(const P& p, const f32x16& a, int m, int nb, int hi, float rs) {
  if (m >= RT) return;
  const int h = nb >> 7, c0 = nb & 127; bf16* base = c0 < 64 ? WSP(bf16, O_KN) : WSP(bf16, O_V); const int c = (c0 & 63) + 4 * hi;
#pragma unroll
  for (int g = 0; g < 4; ++g) { const uint2 w = pack4(a[4 * g] * rs, a[4 * g + 1] * rs, a[4 * g + 2] * rs, a[4 * g + 3] * rs);
    if (m < RX) *(uint2*)(base + (((size_t)(m >> 14) * NH + h) * NKEY + KPAD + NMETA + (m & (SEQ - 1))) * 64 + c + 8 * g) = w;
    else { const int jk = KPAD + (m - RX); *(uint2*)(base + ((size_t)h * NKEY + jk) * 64 + c + 8 * g) = w; *(uint2*)(base + (((size_t)NH + h) * NKEY + jk) * 64 + c + 8 * g) = w; } }
}
__device__ __forceinline__ void phase_kvup(const P& p, int tile, char* lds) {
  const int mt = tile >> 2, nt = tile & 3, m0 = mt * 256, n0 = nt * 256;
  f32x16 acc[4][2]; ALB al{WSP(bf16, O_KVLAT), KVL, RT - 1};
  gemm_main<256, 256, 64, 2, 4, -1>(lds, al, m0, WSP(bf16, O_WTKV), KVL, n0, 1023, KVL, acc);
  const int tid_ = otid(), lane = tid_ & 63, wid = tid_ >> 6, wm = wid >> 2, wn = wid & 3, r32 = lane & 31, hi = lane >> 5;
  const float* rowss = (const float*)(lds + LDS_ROWSS); const int lr = wm * 128 + r32, nb = n0 + wn * 64;
#define KVROW(i) do { const float rs_ = rsqrtf(rowss[lr + 32 * (i)] * (1.f / KVL) + EPS); kvup_epi(p, acc[i][0], m0 + lr + 32 * (i), nb, hi, rs_); kvup_epi(p, acc[i][1], m0 + lr + 32 * (i), nb + 32, hi, rs_); } while (0)
  KVROW(0); KVROW(1); KVROW(2); KVROW(3);
#undef KVROW
  __syncthreads();
}
__device__ __forceinline__ float pair_sum(float v) { return v + __shfl_xor(v, 32); }
constexpr int NT_GLU = 512;
__device__ __forceinline__ void glu_epi(const P& p, const f32x16& av, const f32x16& ag, int m, int q, int hi) {
  const float* bg = WSP(float, O_BGLU); const bf16* sg = WSP(bf16, O_SGATE); bf16* yrow = WSP(bf16, O_YSN) + (size_t)m * DS + q * 32; float part = 0.f;
#pragma unroll
  for (int g = 0; g < 4; ++g) { const int cc = 8 * g + 4 * hi; const f32x4v ba = *(const f32x4v*)(bg + q * 64 + cc), bgt = *(const f32x4v*)(bg + q * 64 + 32 + cc);
    const uint2 gw = *(const uint2*)(sg + (size_t)m * DS + q * 32 + cc); const float gt[4] = {bflo(gw.x), bfhi(gw.x), bflo(gw.y), bfhi(gw.y)}; float v[4];
#pragma unroll
    for (int e = 0; e < 4; ++e) { const float a_ = av[4 * g + e] + ba[e], g_ = ag[4 * g + e] + bgt[e]; v[e] = a_ / (1.f + __expf(-g_)) * gt[e]; part += v[e] * v[e]; }
    *(uint2*)(yrow + cc) = pack4(v[0], v[1], v[2], v[3]); }
  part = pair_sum(part);
  if (hi == 0) WSP(float, O_GPART)[(size_t)q * RX + m] = part;
}
__device__ __forceinline__ void phase_glu(const P& p, int tile, char* lds) {
  const int rnd = tile >> 8, s = tile & 255, xcd = s & 7, slot = s >> 3, mt = rnd * 64 + xcd * 8 + (slot >> 2), nt = slot & 3, m0 = mt * 256;
  f32x16 acc[4][2]; ALBn al{WSP(bf16, O_YSG), DS, RX - 1};
  gemm_main<256, 256, 64, 2, 4, -1>(lds, al, m0, WSP(bf16, O_WTGLU), DS, nt * 256, 1023, DS, acc);
  const int tid_ = otid(), lane = tid_ & 63, wid = tid_ >> 6, wm = wid >> 2, wn = wid & 3, r32 = lane & 31, hi = lane >> 5;
  const int m = m0 + wm * 128 + r32, q = nt * 4 + wn;
  glu_epi(p, acc[0][0], acc[0][1], m, q, hi); glu_epi(p, acc[1][0], acc[1][1], m + 32, q, hi);
  glu_epi(p, acc[2][0], acc[2][1], m + 64, q, hi); glu_epi(p, acc[3][0], acc[3][1], m + 96, q, hi);
  __syncthreads();
}
constexpr int NT_OUT = 512;
__device__ __forceinline__ float out_epi(const P& p, const f32x16& a, int m, int nb, int hi, float sc) {
  bf16* yrow = WSP(bf16, O_Y) + (size_t)m * DM + nb + 4 * hi; float part = 0.f;
#pragma unroll
  for (int g = 0; g < 4; ++g) { const float v0 = a[4 * g] * sc, v1 = a[4 * g + 1] * sc, v2 = a[4 * g + 2] * sc, v3 = a[4 * g + 3] * sc;
    part += v0 * v0 + v1 * v1 + v2 * v2 + v3 * v3; *(uint2*)(yrow + 8 * g) = pack4(v0, v1, v2, v3); }
  return part;
}
__device__ __forceinline__ void phase_out(const P& p, int tile, char* lds) {
  const int rnd = tile >> 8, s = tile & 255, xcd = s & 7, slot = s >> 3, mt = rnd * 64 + xcd * 8 + (slot >> 2), nt = slot & 3, m0 = mt * 256;
  float* isc = (float*)(lds + LDS_RED);
  { const int t = otid(); if (t < 256) { const float* gp = WSP(float, O_GPART) + m0 + t; float sq = 0.f;
#pragma unroll
      for (int q = 0; q < 16; ++q) sq += gp[(size_t)q * RX];
      isc[t] = sqrtf(sq * (1.f / DS) + EPS); } }
  __syncthreads();
  f32x16 acc[4][2]; ALOut al{WSP(bf16, O_YA), WSP(bf16, O_YSN)};
  gemm_main<256, 256, 64, 2, 4, 8>(lds, al, m0, WSP(bf16, O_WTOUT), DM, nt * 256, 1023, DM, acc, isc);
  const int tid_ = otid(), lane = tid_ & 63, wid = tid_ >> 6, wm = wid >> 2, wn = wid & 3, r32 = lane & 31, hi = lane >> 5;
  const int lr = wm * 128 + r32, m = m0 + lr, nb = nt * 256 + wn * 64; float* yp = WSP(float, O_YPART) + (size_t)(nt * 4 + wn) * RX;
#define OUT_ROW(i) do { const float sc_ = 1.f / isc[lr + 32 * (i)]; float part_ = out_epi(p, acc[i][0], m + 32 * (i), nb, hi, sc_) + out_epi(p, acc[i][1], m + 32 * (i), nb + 32, hi, sc_); \
    part_ = pair_sum(part_); if (hi == 0) yp[m + 32 * (i)] = part_; } while (0)
  OUT_ROW(0); OUT_ROW(1); OUT_ROW(2); OUT_ROW(3);
#undef OUT_ROW
  __syncthreads();
}
__device__ __forceinline__ void phase_final(const P& p) {
  const int t = threadIdx.x, rsub = t >> 7, c = (t & 127) * 8; const float* yp = WSP(float, O_YPART);
  const f32x4v w0 = *(const f32x4v*)(p.post_w + c), w1 = *(const f32x4v*)(p.post_w + c + 4);
  for (int row = blockIdx.x * 4 + rsub; row < RX; row += gridDim.x * 4) {
    float sq = 0.f;
#pragma unroll
    for (int q = 0; q < 16; ++q) sq += yp[(size_t)q * RX + row];
    const float rs = rsqrtf(sq * (1.f / DM) + EPS);
    const u32x4 yv = *(const u32x4*)(WSP(bf16, O_Y) + (size_t)row * DM + c);
    const f32x4v x0 = *(const f32x4v*)(p.x + (size_t)row * DM + c), x1 = *(const f32x4v*)(p.x + (size_t)row * DM + c + 4);
    f32x4v o0, o1;
    o0[0] = x0[0] + bflo(yv[0]) * rs * w0[0]; o0[1] = x0[1] + bfhi(yv[0]) * rs * w0[1]; o0[2] = x0[2] + bflo(yv[1]) * rs * w0[2]; o0[3] = x0[3] + bfhi(yv[1]) * rs * w0[3];
    o1[0] = x1[0] + bflo(yv[2]) * rs * w1[0]; o1[1] = x1[1] + bfhi(yv[2]) * rs * w1[1]; o1[2] = x1[2] + bflo(yv[3]) * rs * w1[2]; o1[3] = x1[3] + bfhi(yv[3]) * rs * w1[3];
    *(f32x4v*)(p.out + (size_t)row * DM + c) = o0; *(f32x4v*)(p.out + (size_t)row * DM + c + 4) = o1;
  }
}

using s16x4 = __attribute__((ext_vector_type(4))) short;
constexpr float ATT_SCALE = 0.10206207261596577f;
constexpr float ATT_THR = 8.f;
constexpr int A_SHM_V = 8192, A_SHM_KN = 8192, A_SHM_KR = 4096;
constexpr int A_OFF_V = 0, A_OFF_KN = 2 * A_SHM_V, A_OFF_KR = A_OFF_KN + 2 * A_SHM_KN, A_OFF_WS = A_OFF_KR + 2 * A_SHM_KR;
#define SBAR() __builtin_amdgcn_sched_barrier(0)
__device__ __forceinline__ unsigned cvtpkv(float lo, float hi) { unsigned r; asm volatile("v_cvt_pk_bf16_f32 %0, %1, %2" : "=v"(r) : "v"(lo), "v"(hi)); return r; }
constexpr float ATT_THR2 = 60.f;
__device__ __forceinline__ float rowmaxSM(const f32x16& p0, const f32x16& p1) {
  float pmax = p0[0];
#pragma unroll
  for (int r = 1; r < 16; ++r) pmax = fmaxf(pmax, p0[r]);
#pragma unroll
  for (int r = 0; r < 16; ++r) pmax = fmaxf(pmax, p1[r]);
  auto rr = __builtin_amdgcn_permlane32_swap(__float_as_uint(pmax), __float_as_uint(pmax), false, false);
  return fmaxf(__uint_as_float(rr[0]), __uint_as_float(rr[1]));
}
__device__ __forceinline__ void decideSM(f32x16& p0, f32x16& p1, float pmax, float& m_reg, float& alpha, bool& zref) {
  if (__builtin_expect(__all(pmax <= ATT_THR2), 1)) { alpha = 1.f; }
  else { const float delta = fmaxf(pmax, 0.f); alpha = __builtin_amdgcn_exp2f(-delta); m_reg += delta; zref = false;
#pragma unroll
    for (int r = 0; r < 16; ++r) { p0[r] -= delta; p1[r] -= delta; } }
#pragma unroll
  for (int r = 0; r < 16; ++r) p0[r] = __builtin_amdgcn_exp2f(p0[r]);
}
__device__ __forceinline__ void firstSM(f32x16& p0, f32x16& p1, float pmax, float& m_reg, float& alpha, bool& zref) {
  alpha = 1.f;
  if (!__all(fabsf(pmax) <= ATT_THR2)) { const float delta = fabsf(pmax) <= ATT_THR2 ? 0.f : pmax; m_reg = delta; zref = false;
#pragma unroll
    for (int r = 0; r < 16; ++r) { p0[r] -= delta; p1[r] -= delta; } }
#pragma unroll
  for (int r = 0; r < 16; ++r) p0[r] = __builtin_amdgcn_exp2f(p0[r]);
}
#define SCHEDPAT() do { _Pragma("unroll") for (int i_ = 0; i_ < 10; ++i_) { __builtin_amdgcn_sched_group_barrier(0x008, 2, 0); __builtin_amdgcn_sched_group_barrier(0x100, 4, 0); __builtin_amdgcn_sched_group_barrier(0x002, 9, 0); } } while (0)
template <bool HALF_SUM = false> __device__ __forceinline__ void finishSM(f32x16& p0, f32x16& p1, float alpha, float& l_reg, bf16x8& pa0, bf16x8& pa1, bf16x8& pa2, bf16x8& pa3) {
#pragma unroll
  for (int r = 0; r < 16; ++r) p1[r] = __builtin_amdgcn_exp2f(p1[r]);
  float ps = 0;
#pragma unroll
  for (int r = 0; r < 16; ++r) ps += p0[r];
#pragma unroll
  for (int r = 0; r < 16; ++r) ps += p1[r];
  if (!HALF_SUM) { auto rr = __builtin_amdgcn_permlane32_swap(__float_as_uint(ps), __float_as_uint(ps), false, false);
    ps = __uint_as_float(rr[0]) + __uint_as_float(rr[1]); }
  l_reg = l_reg * alpha + ps;
#define PK4(Pv, BASE, OUT) do { u32x4 w = {cvtpkv(Pv[BASE + 0], Pv[BASE + 1]), cvtpkv(Pv[BASE + 2], Pv[BASE + 3]), cvtpkv(Pv[BASE + 4], Pv[BASE + 5]), cvtpkv(Pv[BASE + 6], Pv[BASE + 7])}; \
    OUT = (bf16x8)w; } while (0)
  PK4(p0, 0, pa0); PK4(p0, 8, pa1); PK4(p1, 0, pa2); PK4(p1, 8, pa3);
#undef PK4
}
__device__ __forceinline__ void qkt(f32x16& p0, f32x16& p1, const char* Kn, const char* Kr, const bf16x8* qr, int r32, int hi, float init) {
#pragma unroll
  for (int r = 0; r < 16; ++r) { p0[r] = init; p1[r] = init; }
#pragma unroll
  for (int d0 = 0; d0 < 4; ++d0) {
    bf16x8 b0 = *(const bf16x8*)(Kn + swz<128>(r32, d0 * 2 + hi));
    bf16x8 b1 = *(const bf16x8*)(Kn + swz<128>(32 + r32, d0 * 2 + hi));
    p0 = __builtin_amdgcn_mfma_f32_32x32x16_bf16(b0, qr[d0], p0, 0, 0, 0);
    p1 = __builtin_amdgcn_mfma_f32_32x32x16_bf16(b1, qr[d0], p1, 0, 0, 0); }
#pragma unroll
  for (int d0 = 0; d0 < 2; ++d0) {
    bf16x8 b0 = *(const bf16x8*)(Kr + swz<64>(r32, d0 * 2 + hi));
    bf16x8 b1 = *(const bf16x8*)(Kr + swz<64>(32 + r32, d0 * 2 + hi));
    p0 = __builtin_amdgcn_mfma_f32_32x32x16_bf16(b0, qr[4 + d0], p0, 0, 0, 0);
    p1 = __builtin_amdgcn_mfma_f32_32x32x16_bf16(b1, qr[4 + d0], p1, 0, 0, 0); }
}
__device__ __forceinline__ int v_st(int k, int c) { const int kk = k;     return ((kk >> 3) * 2 + (c >> 5)) * 512 + ((kk & 7) * 32 + (c & 31)) * 2; }
__device__ __forceinline__ int v_rd_base(int lane) { return ((lane & 3) << 3) | (((lane >> 2) & 3) << 6) | (((lane >> 4) & 1) << 5) | (((lane >> 5) & 1) << 8); }
constexpr int v_rd_off(int d0, int ks, int half) { return d0 * 512 + ks * 2048 + half * 1024; }
template <int OFF> __device__ __forceinline__ s16x4 tr_read(int vb) {
  return __builtin_amdgcn_ds_read_tr16_b64_v4i16((__attribute__((address_space(3))) s16x4*)(uintptr_t)(unsigned)(vb + OFF));
}
template <int D0> __device__ __forceinline__ void pv_one(f32x16& od, int vb, bf16x8 pa0, bf16x8 pa1, bf16x8 pa2, bf16x8 pa3) {
  const s16x4 l0 = tr_read<v_rd_off(D0, 0, 0)>(vb), h0 = tr_read<v_rd_off(D0, 0, 1)>(vb), l1 = tr_read<v_rd_off(D0, 1, 0)>(vb), h1 = tr_read<v_rd_off(D0, 1, 1)>(vb);
  const s16x4 l2 = tr_read<v_rd_off(D0, 2, 0)>(vb), h2 = tr_read<v_rd_off(D0, 2, 1)>(vb), l3 = tr_read<v_rd_off(D0, 3, 0)>(vb), h3 = tr_read<v_rd_off(D0, 3, 1)>(vb);
#define PKV(L, H) (bf16x8){L[0], L[1], L[2], L[3], H[0], H[1], H[2], H[3]}
  od = __builtin_amdgcn_mfma_f32_32x32x16_bf16(PKV(l0, h0), pa0, od, 0, 0, 0);
  od = __builtin_amdgcn_mfma_f32_32x32x16_bf16(PKV(l1, h1), pa1, od, 0, 0, 0);
  od = __builtin_amdgcn_mfma_f32_32x32x16_bf16(PKV(l2, h2), pa2, od, 0, 0, 0);
  od = __builtin_amdgcn_mfma_f32_32x32x16_bf16(PKV(l3, h3), pa3, od, 0, 0, 0);
#undef PKV
}
constexpr int NT_ATTN = NB * NH * (SEQ / 256);
constexpr int ATT_NT = NKEY / 64;
#ifndef ATT_FORCE_FALLBACK
#define ATT_FORCE_FALLBACK 0
#endif
template <bool FAST> __device__ __forceinline__ void attn_item(const P& p, int item, char* lds) {
  const int rnd = item >> 8, s = item & 255, xcd = s & 7, idx = s >> 3;
  const int bh = rnd * 4 + (xcd >> 1), qblk = (xcd & 1) * 32 + idx, b = bh >> 3, h = bh & 7, i0 = qblk * 256;
  const int tid = otid(), wid = tid >> 6, lane = tid & 63, r32 = lane & 31, hi = lane >> 5;
  const bf16* Qb = WSP(bf16, O_Q) + ((size_t)bh * SEQ + i0) * DQK;
  const bf16* Knh = WSP(bf16, O_KN) + (size_t)bh * NKEY * 64; const bf16* Vh = WSP(bf16, O_V) + (size_t)bh * NKEY * 64;
  const bf16* Krb = WSP(bf16, O_KR) + (size_t)b * NKEY * 32;
  char* V_lds = lds + A_OFF_V; char* Kn_lds = lds + A_OFF_KN; char* Kr_lds = lds + A_OFF_KR;
  volatile unsigned* redo = (volatile unsigned*)(lds + A_OFF_WS);
  if (FAST && tid == 0) *redo = 0u;
  float m_reg = 0.f, l_reg = 0; bool zref = true; f32x16 o[2]; bf16x8 qr[6];
#pragma unroll
  for (int r = 0; r < 16; ++r) { o[0][r] = 0.f; o[1][r] = 0.f; }
  const bf16* Qw = Qb + (size_t)(wid * 32 + r32) * DQK + hi * 8;
#pragma unroll
  for (int d0 = 0; d0 < 6; ++d0) qr[d0] = *(const bf16x8*)(Qw + d0 * 16);
  const int sr = tid >> 3, sc = tid & 7;
  const int vst = v_st(sr, sc * 8), knst = swz<128>(sr, sc), krst = swz<64>(sr, sc >> 1) + (sc & 1) * 8;
  const int vb0 = (int)(uintptr_t)V_lds + v_rd_base(lane);
  struct { u32x4 v, kn; uint2 kr; } st_[2];
#define SLOAD(i, k0) do { st_[i].v = *(const u32x4*)(Vh + (size_t)((k0) + sr) * 64 + sc * 8); st_[i].kn = *(const u32x4*)(Knh + (size_t)((k0) + sr) * 64 + sc * 8); \
    st_[i].kr = *(const uint2*)(Krb + (size_t)((k0) + sr) * 32 + sc * 4); } while (0)
#define SWRITE(bq, i) do { *(u32x4*)(V_lds + (bq) * A_SHM_V + vst) = st_[i].v; *(u32x4*)(Kn_lds + (bq) * A_SHM_KN + knst) = st_[i].kn; \
    *(uint2*)(Kr_lds + (bq) * A_SHM_KR + krst) = st_[i].kr; } while (0)
#define SWAIT() asm volatile("s_waitcnt vmcnt(3)" ::: "memory")
#define RESC(a) do { if (__any((a) < 1.f)) { _Pragma("unroll") for (int d = 0; d < 2; ++d) _Pragma("unroll") for (int r = 0; r < 16; ++r) o[d][r] *= (a); } } while (0)
#define PV(vbx) do { pv_one<0>(o[0], (vbx), pa0, pa1, pa2, pa3); pv_one<1>(o[1], (vbx), pa0, pa1, pa2, pa3); } while (0)
  f32x16 pA0, pA1, pB0, pB1; float alA, alB; bf16x8 pa0, pa1, pa2, pa3; constexpr int NT = ATT_NT;
  constexpr int SE = 0, SO = 1;
  if (wid >= 4) __builtin_amdgcn_s_setprio(1);
  SLOAD(SE, 0); asm volatile("s_waitcnt vmcnt(0)" ::: "memory"); SWRITE(0, SE); __syncthreads();
  qkt(pA0, pA1, Kn_lds, Kr_lds, qr, r32, hi, 0.f);
#pragma unroll
  for (int r = 0; r < 16; ++r) pA0[r] = -1e30f;
#pragma unroll
  for (int r = 0; r < 8; ++r) pA1[r] = -1e30f;
  { const float pm_ = rowmaxSM(pA0, pA1); firstSM(pA0, pA1, pm_, m_reg, alA, zref); }
  bool bad = FAST && !zref;
  SLOAD(SO, 64); SLOAD(SE, 128);
  SWAIT(); SWRITE(1, SO); __syncthreads();
  for (int j = 1; j + 1 < NT; j += 2) {
    if (FAST || zref) qkt(pB0, pB1, Kn_lds + A_SHM_KN, Kr_lds + A_SHM_KR, qr, r32, hi, 0.f); else qkt(pB0, pB1, Kn_lds + A_SHM_KN, Kr_lds + A_SHM_KR, qr, r32, hi, -m_reg);
    finishSM<FAST>(pA0, pA1, alA, l_reg, pa0, pa1, pa2, pa3);
    SLOAD(SO, (j + 2 < NT ? j + 2 : NT - 1) * 64);
    PV(vb0);
    if (FAST) { SCHEDPAT(); alB = 1.f; _Pragma("unroll") for (int r = 0; r < 16; ++r) pB0[r] = __builtin_amdgcn_exp2f(pB0[r]); }
    else { const float pm_ = rowmaxSM(pB0, pB1); SCHEDPAT(); decideSM(pB0, pB1, pm_, m_reg, alB, zref); }
    __syncthreads(); SWAIT(); SWRITE(0, SE);
    if (!FAST) RESC(alB);
    __syncthreads();
    if (FAST || zref) qkt(pA0, pA1, Kn_lds, Kr_lds, qr, r32, hi, 0.f); else qkt(pA0, pA1, Kn_lds, Kr_lds, qr, r32, hi, -m_reg);
    finishSM<FAST>(pB0, pB1, alB, l_reg, pa0, pa1, pa2, pa3);
    SLOAD(SE, (j + 3 < NT ? j + 3 : NT - 1) * 64);
    PV(vb0 + A_SHM_V);
    if (FAST) { SCHEDPAT(); alA = 1.f; _Pragma("unroll") for (int r = 0; r < 16; ++r) pA0[r] = __builtin_amdgcn_exp2f(pA0[r]); }
    else { const float pm_ = rowmaxSM(pA0, pA1); SCHEDPAT(); decideSM(pA0, pA1, pm_, m_reg, alA, zref); }
    __syncthreads(); SWAIT(); SWRITE(1, SO);
    if (!FAST) RESC(alA);
    __syncthreads();
  }
  __builtin_amdgcn_s_setprio(0);
  finishSM<FAST>(pA0, pA1, alA, l_reg, pa0, pa1, pa2, pa3); SBAR();
  PV(vb0);
  if (FAST) l_reg += __shfl_xor(l_reg, 32);
  if (FAST) { float chk = l_reg;
#pragma unroll
    for (int r = 0; r < 16; ++r) chk += fabsf(o[0][r]) + fabsf(o[1][r]);
    bad = bad || !(chk < 3.0e38f) || !(l_reg > 0.f) ; if (ATT_FORCE_FALLBACK) { int one_ = 1; asm volatile("" : "+v"(one_)); bad = bad || (one_ != 0); }
    if (__any(bad) && lane == 0) *redo = 1u; }
  { const float rl = __builtin_amdgcn_rcpf(l_reg); const size_t rowoff = (size_t)(b * SEQ + i0 + wid * 32 + r32) * DA + h * 64 + 4 * hi;
    const bf16* gate = WSP(bf16, O_AGATE) + rowoff; bf16* ya = WSP(bf16, O_YA) + rowoff;
#pragma unroll
    for (int d0 = 0; d0 < 2; ++d0)
#pragma unroll
      for (int g = 0; g < 4; ++g) { const uint2 gw = *(const uint2*)(gate + d0 * 32 + 8 * g);
        *(uint2*)(ya + d0 * 32 + 8 * g) = pack4(o[d0][4 * g] * rl * bflo(gw.x), o[d0][4 * g + 1] * rl * bfhi(gw.x), o[d0][4 * g + 2] * rl * bflo(gw.y), o[d0][4 * g + 3] * rl * bfhi(gw.y)); } }
  __syncthreads();
  bool again = false; if (FAST) { again = (*redo != 0u); __syncthreads(); }
#undef SLOAD
#undef SWRITE
#undef SWAIT
#undef RESC
#undef PV
  if (FAST) { if (again) attn_item<false>(p, item, lds); }
}


__device__ __forceinline__ void build_tables_p1(const P& p) {
  const size_t gid = blockIdx.x * 512ull + threadIdx.x, gsz = gridDim.x * 512ull;
  const float2* pw = WSP(float2, O_PW); const float2* bbar = WSP(float2, O_BBAR); float* Kt = WSP(float, O_KT); bf16* WS = WSP(bf16, O_WS);
  for (size_t i = gid; i < (size_t)2 * 32 * 16 * 256; i += gsz) { const int h = i & 15, hp = (i >> 4) & 15, d = (i >> 8) & 15, dg = i >> 12;
    float s = 0.f;
#pragma unroll 8
    for (int pp = 0; pp < 64; ++pp) { const float2 pv = pw[(dg * 64 + pp) * 17 + d]; const float cr = p.c_re[(dg * 16 + hp) * 64 + pp], ci = p.c_im[(dg * 16 + hp) * 64 + pp];
      const float2 bb = bbar[(dg * 64 + pp) * 16 + h]; const float xr = cr * pv.x - ci * pv.y, xi = cr * pv.y + ci * pv.x; s += xr * bb.x - xi * bb.y; }
    Kt[i] = s; }
  for (size_t i8 = gid; i8 < (size_t)32 * 256 * 256 / 8; i8 += gsz) { const size_t i = i8 * 8; const int k = i & 255, n = (i >> 8) & 255, g = i >> 16; const int s = k >> 4, h = k & 15, dirS = n >> 7, pp = (n >> 1) & 63, ri = n & 1;
    const int dg = dirS * 32 + g, e = dirS ? s : 15 - s; const float2 pv = pw[(dg * 64 + pp) * 17 + e]; const float2* bb = bbar + (dg * 64 + pp) * 16 + h; float v[8];
#pragma unroll
    for (int q = 0; q < 8; ++q) { const float2 b_ = bb[q]; v[q] = ri ? (pv.x * b_.y + pv.y * b_.x) : (pv.x * b_.x - pv.y * b_.y); }
    u32x4 w = {cvtpk(v[0], v[1]), cvtpk(v[2], v[3]), cvtpk(v[4], v[5]), cvtpk(v[6], v[7])}; *(u32x4*)(WS + i) = w; }
}
__device__ __forceinline__ void build_tables_p2(const P& p) {
  const size_t gid = blockIdx.x * 512ull + threadIdx.x, gsz = gridDim.x * 512ull;
  const float2* pw = WSP(float2, O_PW); const float* Kt = WSP(float, O_KT); bf16* Msg = WSP(bf16, O_MSG);
  for (size_t i8 = gid; i8 < (size_t)32 * 256 * 512 / 8; i8 += gsz) { const size_t i = i8 * 8; const int k = i & 511, n = (i >> 9) & 255, g = i >> 17; const int t = n >> 4, hp = n & 15; float v[8];
    if (k < 256) { const int s = k >> 4, h = k & 15, o = hp * 16 + h;
      if (s != t) { const float* kt = (s < t) ? Kt + ((size_t)g * 16 + (t - s)) * 256 + o : Kt + ((size_t)(32 + g) * 16 + (s - t)) * 256 + o;
        const f32x4v a = *(const f32x4v*)kt, b = *(const f32x4v*)(kt + 4);
        v[0] = a[0]; v[1] = a[1]; v[2] = a[2]; v[3] = a[3]; v[4] = b[0]; v[5] = b[1]; v[6] = b[2]; v[7] = b[3]; }
      else { const float* k0 = Kt + ((size_t)g * 16) * 256 + o; const float* k1 = Kt + ((size_t)(32 + g) * 16) * 256 + o;
        const f32x4v a = *(const f32x4v*)k0, b = *(const f32x4v*)(k0 + 4), c = *(const f32x4v*)k1, d = *(const f32x4v*)(k1 + 4);
        v[0] = a[0] + c[0]; v[1] = a[1] + c[1]; v[2] = a[2] + c[2]; v[3] = a[3] + c[3]; v[4] = b[0] + d[0]; v[5] = b[1] + d[1]; v[6] = b[2] + d[2]; v[7] = b[3] + d[3]; }
    } else { const int kk = k - 256, dirX = kk >> 7, pp0 = (kk >> 1) & 63, dg = dirX * 32 + g, e = dirX ? 16 - t : t + 1;
#pragma unroll
      for (int q = 0; q < 4; ++q) { const int pp = pp0 + q; const float2 pv = pw[(dg * 64 + pp) * 17 + e]; const float cr = p.c_re[(dg * 16 + hp) * 64 + pp], ci = p.c_im[(dg * 16 + hp) * 64 + pp];
        v[2 * q] = cr * pv.x - ci * pv.y; v[2 * q + 1] = -(cr * pv.y + ci * pv.x); } }
    u32x4 w = {cvtpk(v[0], v[1]), cvtpk(v[2], v[3]), cvtpk(v[4], v[5]), cvtpk(v[6], v[7])}; *(u32x4*)(Msg + i) = w; }
}
constexpr int NT_SSMS = 256, NT_SSMY = 512;
__device__ __forceinline__ void phase_ssmS(const P& p, int tile, char* lds) {
  const int g = tile >> 3, mt = tile & 7, m0 = mt * 256;
  f32x16 acc[4][2]; ALBn al{WSP(bf16, O_SUG) + (size_t)g * RP * GH, 256, 2047};
  gemm_main<256, 256, 64, 2, 4, -1>(lds, al, m0, WSP(bf16, O_WS) + (size_t)g * 65536, 256, 0, 255, 256, acc);
  const int tid_ = otid(), lane = tid_ & 63, wid = tid_ >> 6, wm = wid >> 2, wn = wid & 3, r32 = lane & 31, hi = lane >> 5;
  float* S = WSP(float, O_S) + (size_t)g * 2048 * 256;
#pragma unroll
  for (int i = 0; i < 4; ++i)
#pragma unroll
    for (int j = 0; j < 2; ++j)
#pragma unroll
      for (int q = 0; q < 4; ++q) { f32x4v t4 = {acc[i][j][4 * q], acc[i][j][4 * q + 1], acc[i][j][4 * q + 2], acc[i][j][4 * q + 3]};
        *(f32x4v*)(S + (size_t)(m0 + wm * 128 + i * 32 + r32) * 256 + wn * 64 + j * 32 + 8 * q + 4 * hi) = t4; }
  __syncthreads();
}
struct ALU3 { const bf16* u; const bf16* xa; using Raw = u32x4;
  __device__ __forceinline__ Raw load(int m, int k) const { return *(const u32x4*)(k < 256 ? u + (size_t)m * 256 + k : xa + (size_t)m * 256 + (k - 256)); }
  __device__ __forceinline__ bf16x8 cvt(const Raw& v, int k, float& ss) const { return (bf16x8)v; } };
__device__ __forceinline__ void phase_ssmY(const P& p, int tile, char* lds) {
  const int g = tile >> 4, mt = (tile >> 1) & 7, nt = tile & 1, m0 = mt * 256, n0 = nt * 128;
  const bf16* ug = WSP(bf16, O_SUG) + (size_t)g * RP * GH;
  f32x16 acc[2][2]; ALU3 al{ug, WSP(bf16, O_XA) + (size_t)g * 2048 * 256};
  gemm_main<256, 128, 64, 4, 2, -1>(lds, al, m0, WSP(bf16, O_MSG) + (size_t)g * 256 * 512, 512, n0, 255, 512, acc);
  const int tid_ = otid(), lane = tid_ & 63, wid = tid_ >> 6, wm = wid >> 1, wn = wid & 1, r32 = lane & 31, hi = lane >> 5;
  bf16* ysg = WSP(bf16, O_YSG);
#pragma unroll
  for (int i = 0; i < 2; ++i)
#pragma unroll
    for (int j = 0; j < 2; ++j) { const int m = m0 + wm * 64 + i * 32 + r32;
#pragma unroll
      for (int q = 0; q < 4; ++q) { const int n = n0 + wn * 64 + j * 32 + 8 * q + 4 * hi, t = n >> 4, hp = n & 15;
        const f32x4v dd = *(const f32x4v*)(p.ssm_d + g * 16 + hp); const uint2 uw = *(const uint2*)(ug + (size_t)m * 256 + n);
        const float y0 = acc[i][j][4 * q] + dd[0] * bflo(uw.x), y1 = acc[i][j][4 * q + 1] + dd[1] * bfhi(uw.x), y2 = acc[i][j][4 * q + 2] + dd[2] * bflo(uw.y), y3 = acc[i][j][4 * q + 3] + dd[3] * bfhi(uw.y);
        *(uint2*)(ysg + ((size_t)m * 16 + t) * DS + g * 16 + hp) = pack4(gelu_tanh(y0), gelu_tanh(y1), gelu_tanh(y2), gelu_tanh(y3)); } }
  __syncthreads();
}
__device__ __forceinline__ float2 cmul(float2 a, float2 b) { return make_float2(a.x * b.x - a.y * b.y, a.x * b.y + a.y * b.x); }
__device__ __forceinline__ float2 cfma(float2 a, float2 x, float2 s) { return make_float2(a.x * x.x - a.y * x.y + s.x, a.x * x.y + a.y * x.x + s.y); }
__device__ __forceinline__ void phase_carry1(const P& p) {
  const int nthr = 2 * 32 * 2 * 32 * 64; const float2* pw = WSP(float2, O_PW); float2* E = WSP(float2, O_E);
  for (int idx = blockIdx.x * 512 + threadIdx.x; idx < nthr; idx += gridDim.x * 512) {
    const int pp = idx & 63, sc = (idx >> 6) & 31, dir = (idx >> 11) & 1, g = (idx >> 12) & 31, b = idx >> 17;
    const float2 a16 = pw[((dir * 32 + g) * 64 + pp) * 17 + 16];
    const float* S = WSP(float, O_S) + ((size_t)g * 2048 + b * 1024) * 256 + dir * 128 + pp * 2; float2 X = make_float2(0.f, 0.f);
    for (int q = 0; q < 32; ++q) { const int c = sc * 32 + (dir ? 31 - q : q); const float2 s = *(const float2*)(S + (size_t)c * 256); X = cfma(a16, X, s); }
    E[idx] = X; }
}
__device__ __forceinline__ void phase_carry2(const P& p) {
  const int nthr = 2 * 32 * 2 * 32 * 64; const float2* pw = WSP(float2, O_PW); const float2* E = WSP(float2, O_E); const float2* bbar = WSP(float2, O_BBAR);
  for (int idx = blockIdx.x * 512 + threadIdx.x; idx < nthr; idx += gridDim.x * 512) {
    const int pp = idx & 63, sc = (idx >> 6) & 31, dir = (idx >> 11) & 1, g = (idx >> 12) & 31, b = idx >> 17;
    const int dgp = (dir * 32 + g) * 64 + pp; const float2 a16 = pw[dgp * 17 + 16];
    float2 a512 = a16;
#pragma unroll
    for (int q = 0; q < 5; ++q) a512 = cmul(a512, a512);
    float2 X = make_float2(0.f, 0.f); const float2* Eb = E + (idx & ~(31 << 6) & ~63) + pp;
    if (dir == 0) {
      const bf16* um = WSP(bf16, O_SUG) + ((size_t)g * RP + RX) * GH;
      for (int s = 0; s < 16; ++s) { float2 bu = make_float2(0.f, 0.f);
        for (int h = 0; h < 16; ++h) { const float u = bf2f(um[s * 16 + h]); const float2 bb = bbar[dgp * 16 + h]; bu.x += bb.x * u; bu.y += bb.y * u; }
        X = cfma(pw[dgp * 17 + 1], X, bu); }
      for (int j = 0; j < sc; ++j) X = cfma(a512, X, Eb[j * 64]);
    } else {
      for (int j = 31; j > sc; --j) X = cfma(a512, X, Eb[j * 64]);
    }
    const float* S = WSP(float, O_S) + ((size_t)g * 2048 + b * 1024) * 256 + dir * 128 + pp * 2;
    bf16* XA = WSP(bf16, O_XA) + ((size_t)g * 2048 + b * 1024) * 256 + dir * 128 + pp * 2;
    for (int q = 0; q < 32; ++q) { const int c = sc * 32 + (dir ? 31 - q : q);
      *(unsigned*)(XA + (size_t)c * 256) = cvtpk(X.x, X.y);
      const float2 s = *(const float2*)(S + (size_t)c * 256); X = cfma(a16, X, s); }
  }
}


#define XB_TMO      128
#define XB_XCNT(j)  (256  + 64 * (j))
#define XB_XSUB(j)  (1280 + 64 * (j))
#define XB_XGEN(j)  (2304 + 64 * (j))
#define XB_TOP      3328
#define XB_TOPGEN   3392
#define XCD_BAR_WORDS 3456
#define XB_SPIN_CAP (1u << 22)
#define LAS __attribute__((address_space(3)))
__device__ __forceinline__ unsigned xb_ld(unsigned* p)              { return __hip_atomic_load(p, __ATOMIC_RELAXED, __HIP_MEMORY_SCOPE_AGENT); }
__device__ __forceinline__ unsigned xb_add(unsigned* p, unsigned v) { return __hip_atomic_fetch_add(p, v, __ATOMIC_RELAXED, __HIP_MEMORY_SCOPE_AGENT); }
__device__ __forceinline__ unsigned xb_xcc_id() { return (unsigned)__builtin_amdgcn_s_getreg((3 << 11) | 20) & 0xFu; }
#define XB_SPIN(cond, bar) do { unsigned _sp = 0; while (cond) { __builtin_amdgcn_s_sleep(1); \
    if ((++_sp & 255u) == 0u) { if (xb_ld(&(bar)[XB_TMO])) break; if (_sp > XB_SPIN_CAP) { atomicAdd(&(bar)[XB_TMO], 1u); break; } } } } while (0)
struct XcdBarrier { unsigned* bar; unsigned x; volatile LAS unsigned* st; };
__device__ __forceinline__ XcdBarrier xcd_barrier_post(unsigned* bar, volatile LAS unsigned* st) {
  XcdBarrier b; b.bar = bar; b.x = xb_xcc_id(); b.st = st;
  if (threadIdx.x == 0) (void)xb_add(&bar[XB_XCNT(b.x)], 1u);
  return b;
}
__device__ __forceinline__ void xcd_barrier_complete(unsigned* bar, unsigned x, unsigned& nloc, unsigned& nx) {
  const unsigned G = gridDim.x * gridDim.y * gridDim.z; unsigned sum, cnt, mine, sp = 0u;
  for (;;) {
    sum = 0u; cnt = 0u; mine = 0u;
#pragma unroll
    for (unsigned j = 0; j < 16; ++j) { const unsigned c = xb_ld(&bar[XB_XCNT(j)]); sum += c; cnt += (c > 0u) ? 1u : 0u; mine = (j == x) ? c : mine; }
    if (sum == G) break;
    __builtin_amdgcn_s_sleep(1);
    if ((++sp & 255u) == 0u) { if (xb_ld(&bar[XB_TMO])) break; if (sp > XB_SPIN_CAP) { atomicAdd(&bar[XB_TMO], 1u); break; } }
  }
  nloc = mine > 0u ? mine : 1u; nx = cnt > 0u ? cnt : 1u;
}
__device__ __forceinline__ void xcd_barrier(const XcdBarrier& b) {
  asm volatile("s_waitcnt vmcnt(0)" ::: "memory");
  __syncthreads();
  if (threadIdx.x == 0) {
    unsigned* bar = b.bar;
    __builtin_amdgcn_s_waitcnt(0);
    unsigned nloc = b.st[0], nx = b.st[1];
    if (nloc == 0u) { xcd_barrier_complete(bar, b.x, nloc, nx); b.st[0] = nloc; b.st[1] = nx; }
    const unsigned old = xb_add(&bar[XB_XSUB(b.x)], 1u);
    const unsigned gen = old / nloc;
    if (old + 1u == (gen + 1u) * nloc) {
      __builtin_amdgcn_fence(__ATOMIC_RELEASE, "agent");
      asm volatile("s_waitcnt vmcnt(0)" ::: "memory");
      const unsigned og = xb_add(&bar[XB_TOP], 1u);
      const unsigned tg = og / nx;
      if (og + 1u == (tg + 1u) * nx) xb_add(&bar[XB_TOPGEN], 1u);
      else XB_SPIN(xb_ld(&bar[XB_TOPGEN]) == tg, bar);
      __builtin_amdgcn_fence(__ATOMIC_ACQUIRE, "agent");
      xb_add(&bar[XB_XGEN(b.x)], 1u);
      asm volatile("s_waitcnt vmcnt(0)" ::: "memory");
    } else {
      XB_SPIN(xb_ld(&bar[XB_XGEN(b.x)]) == gen, bar);
      __builtin_amdgcn_fence(__ATOMIC_ACQUIRE, "agent");
      asm volatile("s_waitcnt vmcnt(0)" ::: "memory");
    }
  }
  __syncthreads();
}

__global__ void __launch_bounds__(512) k_mega(P p) {
  __shared__ __attribute__((aligned(16))) char lds[LDS_BYTES];
  cg::grid_group grid = cg::this_grid();
  __shared__ uint4 xb_words;
  if (threadIdx.x == 0) xb_words = make_uint4(0u, 0u, 0u, 0u);
  __syncthreads();
  XcdBarrier xbar = xcd_barrier_post(WSP(unsigned, O_BAR), (volatile LAS unsigned*)&xb_words);
#define GSYNC() do { for (int q_ = 0; q_ < REP_SYNC; ++q_) xcd_barrier(xbar); } while (0)
  prep_all(p, lds);
  grid.sync();
  build_tables_p1(p);
  for (int rep = 0; rep < REP_INPROJ; ++rep) for (int t = blockIdx.x; t < NT_INPROJ; t += gridDim.x) phase_inproj(p, t, lds);
  GSYNC();
  build_tables_p2(p);
  for (int rep = 0; rep < REP_P2; ++rep)
  for (int t = blockIdx.x; t < NT_QUP + NT_KVUP + NT_SSMS; t += gridDim.x) { if (t < NT_QUP) phase_qup(p, t, lds); else if (t < NT_QUP + NT_KVUP) phase_kvup(p, t - NT_QUP, lds); else phase_ssmS(p, t - NT_QUP - NT_KVUP, lds); }
  GSYNC();
  phase_carry1(p);
  GSYNC();
  phase_carry2(p);
  GSYNC();
  for (int rep = 0; rep < REP_ATTN; ++rep)
  for (int t = blockIdx.x; t < NT_ATTN + NT_SSMY; t += gridDim.x) { if (t < NT_ATTN) attn_item<true>(p, t, lds); else phase_ssmY(p, t - NT_ATTN, lds); }
  GSYNC();
  for (int rep = 0; rep < REP_GLU; ++rep) for (int t = blockIdx.x; t < NT_GLU; t += gridDim.x) phase_glu(p, t, lds);
  GSYNC();
  for (int rep = 0; rep < REP_OUT; ++rep) for (int t = blockIdx.x; t < NT_OUT; t += gridDim.x) phase_out(p, t, lds);
  GSYNC();
  for (int rep = 0; rep < REP_FIN; ++rep) phase_final(p);
}

extern "C" void kernel_launch(void* const* d_in, const int* in_sizes, int n_in, void* d_out, int out_size, void* d_ws, size_t ws_size, hipStream_t stream) {
  P p{};
  const float** f = (const float**)&p;
  for (int i = 0; i < 22; ++i) f[i] = (const float*)d_in[i];
  p.out = (float*)d_out; p.ws = (char*)d_ws;
  if (ws_size < O_END) { fprintf(stderr, "ws too small\n"); return; }
  static int grid_blocks = 0;
  if (!grid_blocks) {
    int dev = 0, cus = 0, per_cu = 0; hipGetDevice(&dev);
    hipDeviceGetAttribute(&cus, hipDeviceAttributeMultiprocessorCount, dev);
    hipOccupancyMaxActiveBlocksPerMultiprocessor(&per_cu, k_mega, 512, 0);
    if (per_cu < 1) per_cu = 1;
    grid_blocks = cus * per_cu;
  }
  hipMemsetAsync((char*)d_ws + O_BAR, 0, 4096 * 4, stream);
  void* args[] = {&p};
  hipError_t e = hipLaunchCooperativeKernel((void*)k_mega, dim3(grid_blocks), dim3(512), args, 0, stream);
  if (e != hipSuccess) fprintf(stderr, "cooperative launch failed: %s (grid %d)\n", hipGetErrorString(e), grid_blocks);
}
```

```cpp
#include <hip/hip_runtime.h>
#include <hip/hip_bf16.h>
#include <hip/hip_cooperative_groups.h>
#include <cstdio>
namespace cg = cooperative_groups;
#include <stdint.h>
typedef __hip_bfloat16 bf16;
#ifndef REP_ATTN
#define REP_ATTN 1
#endif
#ifndef REP_INPROJ
#define REP_INPROJ 1
#endif
#ifndef REP_TAIL
#define REP_TAIL 1
#endif
#ifndef REP_P2
#define REP_P2 1
#endif
#ifndef REP_GLU
#define REP_GLU 1
#endif
#ifndef REP_OUT
#define REP_OUT 1
#endif
#ifndef REP_FIN
#define REP_FIN 1
#endif
#ifndef REP_SYNC
#define REP_SYNC 1
#endif

constexpr int DM = 1024, SEQ = 16384, NB = 2, NMETA = 16, LTOT = SEQ + NMETA;
constexpr int DIN = 1952, QL = 256, KVL = 128, QR = 32, DA = 512, DS = 512;
constexpr int NH = 8, DQK = 96, DV = 64, NG = 32, GH = 16, NP = 64;
constexpr int RX = NB * SEQ;
constexpr int RT = RX + NMETA;
constexpr int RP = 33024;
constexpr int KPAD = 48;
constexpr int NKEY = LTOT + KPAD;
constexpr float EPS = 1e-6f;
constexpr int LDK = DM + 64;

constexpr size_t al(size_t x) { return (x + 255) / 256 * 256; }
constexpr size_t O_WTIN = 0;
constexpr size_t O_WTQ = O_WTIN + al((size_t)DIN * LDK * 2);
constexpr size_t O_WTKV = O_WTQ + al((size_t)768 * QL * 2);
constexpr size_t O_WTGLU = O_WTKV + al((size_t)1024 * KVL * 2);
constexpr size_t O_WTOUT = O_WTGLU + al((size_t)1024 * DS * 2);
constexpr size_t O_BGLU = O_WTOUT + al((size_t)DM * DM * 2);
constexpr size_t O_ROPE = O_BGLU + al(1024 * 4);
constexpr size_t O_ABAR = O_ROPE + al((size_t)LTOT * 16 * 8);
constexpr size_t O_BBAR = O_ABAR + al(2 * 32 * 64 * 8);
constexpr size_t O_QLAT = O_BBAR + al(2 * 32 * 64 * 16 * 8);
constexpr size_t O_KVLAT = O_QLAT + al((size_t)RP * QL * 2);
constexpr size_t O_AGATE = O_KVLAT + al((size_t)RP * KVL * 2);
constexpr size_t O_SGATE = O_AGATE + al((size_t)RX * DA * 2);
constexpr size_t O_SUG = O_SGATE + al((size_t)RX * DS * 2);
constexpr size_t O_KN = O_SUG + al((size_t)NG * RP * GH * 2);
constexpr size_t O_V = O_KN + al((size_t)NB * NH * NKEY * 64 * 2);
constexpr size_t O_KR = O_V + al((size_t)NB * NH * NKEY * 64 * 2);
constexpr size_t O_Q = O_KR + al((size_t)NB * NKEY * 32 * 2);
constexpr size_t O_YA = O_Q + al((size_t)NB * NH * SEQ * DQK * 2);
constexpr size_t O_YSG = O_YA + al((size_t)RX * DA * 2);
constexpr size_t O_YSN = O_YSG + al((size_t)RX * DS * 2);
constexpr size_t O_RSX = O_YSN + al((size_t)RX * DS * 2);
constexpr size_t O_RSQ = O_RSX + al(RP * 4);
constexpr size_t O_RSKV = O_RSQ + al(RP * 4);
constexpr size_t O_RSA = O_RSKV + al(RP * 4);
constexpr size_t O_PW = O_RSA + al(RP * 4);
constexpr size_t O_KT = O_PW + al(2 * 32 * 64 * 17 * 8);
constexpr size_t O_WS = O_KT + al(2 * 32 * 16 * 256 * 4);
constexpr size_t O_MSG = O_WS + al((size_t)32 * 256 * 256 * 2);
constexpr size_t O_S = O_MSG + al((size_t)32 * 256 * 512 * 2);
constexpr size_t O_XB = O_S;
constexpr size_t O_E = O_S + al((size_t)RP * LDK * 2);
constexpr size_t O_XA = O_E + al((size_t)2 * 32 * 2 * 32 * 64 * 8);
constexpr size_t O_BAR = O_XA + al((size_t)32 * 2048 * 256 * 2);
constexpr size_t O_GPART = O_BAR + al(4096 * 4);
constexpr size_t O_YPART = O_GPART + al((size_t)16 * RX * 4);
constexpr size_t O_Y = O_S;
constexpr size_t O_END = O_YPART + al((size_t)16 * RX * 4);

struct P {
  const float *x, *meta, *pre_w, *post_w, *w_in, *qn_w, *w_qup, *kvn_w, *w_kvup, *aon_w;
  const float *a_re, *a_im, *log_dt, *b_re, *b_im, *c_re, *c_im, *ssm_d, *w_glu, *b_glu, *son_w, *w_out;
  float* out; char* ws;
};
#define WSP(T, off) ((T*)(p.ws + (off)))

__device__ __forceinline__ float bf2f(bf16 v) { return __bfloat162float(v); }
__device__ __forceinline__ bf16 f2bf(float v) { return __float2bfloat16(v); }
__device__ __forceinline__ float silu(float v) { return v / (1.f + __expf(-v)); }
__device__ __forceinline__ float gelu_tanh(float v) {
  const float u = 0.7978845608028654f * (v + 0.044715f * v * v * v);
  return v / (1.f + __expf(-2.f * u));
}
__device__ __forceinline__ const float* xrow(const P& p, int r) {
  return r < RX ? p.x + (size_t)r * DM : p.meta + (size_t)(r - RX) * DM;
}
__device__ __forceinline__ void sincos_red(double ang, float& c, float& s) {
  const double TWO_PI = 6.283185307179586476925;
  double n = rint(ang / TWO_PI); float r = (float)(ang - n * TWO_PI);
  c = cosf(r); s = sinf(r);
}

using bf16x8 = __attribute__((ext_vector_type(8))) short;
using f32x16 = __attribute__((ext_vector_type(16))) float;
using f32x4v = __attribute__((ext_vector_type(4))) float;
using u32x4 = __attribute__((ext_vector_type(4))) unsigned;
__device__ __forceinline__ int otid() { int t = threadIdx.x; asm volatile("" : "+v"(t)); return t; }
__device__ __forceinline__ int crow(int r, int hi) { return (r & 3) + 8 * (r >> 2) + 4 * hi; }
__device__ __forceinline__ unsigned cvtpk(float lo, float hi) { unsigned r; asm("v_cvt_pk_bf16_f32 %0, %1, %2" : "=v"(r) : "v"(lo), "v"(hi)); return r; }
__device__ __forceinline__ float bflo(unsigned u) { return __uint_as_float(u << 16); }
__device__ __forceinline__ float bfhi(unsigned u) { return __uint_as_float(u & 0xffff0000u); }
__device__ __forceinline__ void stbf(bf16* dst, float v) { *(unsigned short*)dst = (unsigned short)(cvtpk(v, v) & 0xffffu); }

__device__ __forceinline__ void prep_transposes(const P& p, char* lds) {
  float* T = (float*)lds; const int tid = threadIdx.x;
  constexpr int T_IN = 16 * 31, T_OUT = 16 * 16, T_GLU = 8 * 16, T_Q = 4 * 12, T_KV = 2 * 16, T_ALL = T_IN + T_OUT + T_GLU + T_Q + T_KV;
  for (int t = blockIdx.x; t < T_ALL; t += gridDim.x) {
    const float* W; const float* g0; const float* g1 = nullptr; bf16* dst; int N, ldk, kt, nt_, which;
    if (t < T_IN) { which = 0; W = p.w_in; g0 = p.pre_w; dst = WSP(bf16, O_WTIN); N = DIN; ldk = LDK; kt = t / 31; nt_ = t % 31; }
    else if (t < T_IN + T_OUT) { const int u = t - T_IN; which = 1; W = p.w_out; g0 = p.aon_w; g1 = p.son_w; dst = WSP(bf16, O_WTOUT); N = DM; ldk = DM; kt = u >> 4; nt_ = u & 15; }
    else if (t < T_IN + T_OUT + T_GLU) { const int u = t - T_IN - T_OUT; which = 2; W = p.w_glu; g0 = nullptr; dst = WSP(bf16, O_WTGLU); N = 1024; ldk = DS; kt = u >> 4; nt_ = u & 15; }
    else if (t < T_IN + T_OUT + T_GLU + T_Q) { const int u = t - T_IN - T_OUT - T_GLU; which = 3; W = p.w_qup; g0 = p.qn_w; dst = WSP(bf16, O_WTQ); N = 768; ldk = QL; kt = u / 12; nt_ = u % 12; }
    else { const int u = t - T_IN - T_OUT - T_GLU - T_Q; which = 4; W = p.w_kvup; g0 = p.kvn_w; dst = WSP(bf16, O_WTKV); N = 1024; ldk = KVL; kt = u >> 4; nt_ = u & 15; }
    const int k0 = kt * 64, n0 = nt_ * 64;
#pragma unroll
    for (int i = 0; i < 8; ++i) { const int kk = (tid >> 6) + 8 * i, nn = tid & 63, k = k0 + kk, n = n0 + nn;
      float gk = 1.f; if (which == 1) gk = k < 512 ? g0[k] : g1[k - 512]; else if (g0) gk = g0[k];
      T[kk * 65 + nn] = (n < N) ? W[(size_t)k * N + n] * gk : 0.f; }
    __syncthreads();
    { const int nn = tid >> 3, kc = tid & 7, n = n0 + nn;
      if (n < N) { int row = n; if (which == 2) row = n < 512 ? ((n >> 5) * 64 + (n & 31)) : (((n - 512) >> 5) * 64 + 32 + (n & 31));
        float v[8];
#pragma unroll
        for (int e = 0; e < 8; ++e) v[e] = T[(kc * 8 + e) * 65 + nn];
        u32x4 w = {cvtpk(v[0], v[1]), cvtpk(v[2], v[3]), cvtpk(v[4], v[5]), cvtpk(v[6], v[7])};
        *(u32x4*)(dst + (size_t)row * ldk + k0 + kc * 8) = w; } }
    __syncthreads();
  }
}
__device__ __forceinline__ void prep_all(const P& p, char* lds) {
  const size_t gid = blockIdx.x * (size_t)blockDim.x + threadIdx.x, gsz = gridDim.x * (size_t)blockDim.x;
  prep_transposes(p, lds);
  { float* bglu = WSP(float, O_BGLU);
    for (size_t i = gid; i < 1024; i += gsz) { const int sc = (int)i; const int n = sc < 512 ? ((sc >> 5) * 64 + (sc & 31)) : (((sc - 512) >> 5) * 64 + 32 + (sc & 31)); bglu[n] = p.b_glu[sc]; } }
  { const int lane = threadIdx.x & 63; bf16* xb = WSP(bf16, O_XB); float* rsx = WSP(float, O_RSX);
    for (size_t row = gid >> 6; row < (size_t)RT; row += gsz >> 6) { const float* xr = xrow(p, (int)row); float ss = 0.f;
#pragma unroll
      for (int q = 0; q < 4; ++q) { const f32x4v v = *(const f32x4v*)(xr + q * 256 + lane * 4); ss += v[0] * v[0] + v[1] * v[1] + v[2] * v[2] + v[3] * v[3];
        uint2 w; w.x = cvtpk(v[0], v[1]); w.y = cvtpk(v[2], v[3]); *(uint2*)(xb + row * LDK + q * 256 + lane * 4) = w; }
#pragma unroll
      for (int o = 32; o > 0; o >>= 1) ss += __shfl_xor(ss, o);
      if (lane == 0) rsx[row] = rsqrtf(ss * (1.f / DM) + EPS); } }
  float2* rope = WSP(float2, O_ROPE);
  for (size_t i = gid; i < (size_t)LTOT * 16; i += gsz) {
    int pos = i / 16, j = i % 16; float inv = powf(10000.f, -(float)j / 16.f); float ang = (float)pos * inv;
    float c, s; sincos_red((double)ang, c, s); rope[i] = make_float2(c, s); }
  float2* abar = WSP(float2, O_ABAR); float2* bbar = WSP(float2, O_BBAR);
  for (size_t i = gid; i < 2 * 32 * 64; i += gsz) {
    int dg = i / 64; double dt = exp((double)p.log_dt[dg]); double are = p.a_re[i], aim = p.a_im[i];
    double mag = exp(are * dt); float c, s; sincos_red(aim * dt, c, s);
    double br = mag * (double)c, bi = mag * (double)s;
    br = mag * cos(aim * dt); bi = mag * sin(aim * dt);
    abar[i] = make_float2((float)br, (float)bi);
    { float2* pw = WSP(float2, O_PW) + i * 17;
      double pr = 1.0, pi_ = 0.0;
      for (int d = 0; d <= 16; ++d) { pw[d] = make_float2((float)pr, (float)pi_); const double nr_ = pr * br - pi_ * bi, ni_ = pr * bi + pi_ * br; pr = nr_; pi_ = ni_; } }
    double nr = br - 1.0, ni = bi, den = are * are + aim * aim;
    double cr = (nr * are + ni * aim) / den, ci = (ni * are - nr * aim) / den;
    for (int h = 0; h < 16; ++h) { double b_r = p.b_re[i * 16 + h], b_i = p.b_im[i * 16 + h];
      bbar[i * 16 + h] = make_float2((float)(cr * b_r - ci * b_i), (float)(cr * b_i + ci * b_r)); }
  }
  bf16* kn = WSP(bf16, O_KN); bf16* vv = WSP(bf16, O_V); bf16* kr = WSP(bf16, O_KR);
  for (size_t i = gid; i < (size_t)NB * NH * KPAD * 64; i += gsz) { size_t bh = i / (KPAD * 64), rem = i % (KPAD * 64); kn[bh * NKEY * 64 + rem] = f2bf(0.f); vv[bh * NKEY * 64 + rem] = f2bf(0.f); }
  for (size_t i = gid; i < (size_t)NB * KPAD * 32; i += gsz) { size_t b = i / (KPAD * 32), rem = i % (KPAD * 32); kr[b * NKEY * 32 + rem] = f2bf(0.f); }
}

template <int RB> __device__ __forceinline__ int swz(int row, int chunk) { return row * RB + ((chunk ^ ((row / (256 / RB)) & (RB / 16 - 1))) << 4); }

constexpr int LDS_ROWSS = 131072;
constexpr int LDS_RED = LDS_ROWSS + 1024;
constexpr int LDS_BYTES = LDS_RED + 2048;

struct ALX {
  const float* x; const float* meta;
  struct Raw { f32x4v a, b; };
  __device__ __forceinline__ Raw load(int m, int k) const { m = m < RT ? m : RT - 1;
    const float* r = (m < RX ? x + (size_t)m * DM : meta + (size_t)(m - RX) * DM) + k; Raw v; v.a = *(const f32x4v*)r; v.b = *(const f32x4v*)(r + 4); return v; }
  __device__ __forceinline__ bf16x8 cvt(const Raw& v, int k, float& ss) const {
    ss += v.a[0] * v.a[0] + v.a[1] * v.a[1] + v.a[2] * v.a[2] + v.a[3] * v.a[3] + v.b[0] * v.b[0] + v.b[1] * v.b[1] + v.b[2] * v.b[2] + v.b[3] * v.b[3];
    u32x4 w = {cvtpk(v.a[0], v.a[1]), cvtpk(v.a[2], v.a[3]), cvtpk(v.b[0], v.b[1]), cvtpk(v.b[2], v.b[3])}; return (bf16x8)w; }
};
__device__ __forceinline__ float ss8(u32x4 v) { float s = 0.f;
#pragma unroll
  for (int j = 0; j < 4; ++j) { float a = bflo(v[j]), b = bfhi(v[j]); s += a * a + b * b; } return s; }
struct ALB {
  const bf16* a; int ld; int mmax; using Raw = u32x4;
  __device__ __forceinline__ Raw load(int m, int k) const { m = m < mmax ? m : mmax; return *(const u32x4*)(a + (size_t)m * ld + k); }
  __device__ __forceinline__ bf16x8 cvt(const Raw& v, int k, float& ss) const { ss += ss8(v); return (bf16x8)v; }
};
struct ALBn {
  const bf16* a; int ld; int mmax; using Raw = u32x4;
  __device__ __forceinline__ Raw load(int m, int k) const { m = m < mmax ? m : mmax; return *(const u32x4*)(a + (size_t)m * ld + k); }
  __device__ __forceinline__ bf16x8 cvt(const Raw& v, int k, float& ss) const { return (bf16x8)v; }
};
struct ALOut {
  const bf16* ya; const bf16* ysn; using Raw = u32x4;
  __device__ __forceinline__ Raw load(int m, int k) const { return *(const u32x4*)(k < 512 ? ya + (size_t)m * 512 + k : ysn + (size_t)m * 512 + (k - 512)); }
  __device__ __forceinline__ bf16x8 cvt(const Raw& v, int k, float& ss) const { if (k < 512) ss += ss8(v); return (bf16x8)v; }
};

template <int BM, int BN, int BK, int WGM, int WGN, int MIDKT, class AL>
__device__ __forceinline__ void gemm_main(char* lds, const AL& al, int m0, const bf16* __restrict__ Bt, int ldb, int n0, int nmax, int K,
                                          f32x16 (&acc)[BM / WGM / 32][BN / WGN / 32], const float* midsc = nullptr) {
  constexpr int CPR = BK / 8, RB = BK * 2, RPS = 512 / CPR, A_CH = (BM + RPS - 1) / RPS, B_CH = BN / RPS;
  constexpr int TM = BM / WGM / 32, TN = BN / WGN / 32, A_BYTES = BM * RB, STAGE = (BM + BN) * RB;
  const int tid = otid(), lane = tid & 63, wid = tid >> 6, wm = wid / WGN, wn = wid % WGN, r32 = lane & 31, hi = lane >> 5;
  const int srow = tid / CPR, sch = tid % CPR;
  float* rowss = (float*)(lds + LDS_ROWSS);
  typename AL::Raw ra[A_CH]; u32x4 rb[B_CH]; float ss[A_CH];
#pragma unroll
  for (int i = 0; i < A_CH; ++i) ss[i] = 0.f;
#pragma unroll
  for (int i = 0; i < TM; ++i)
#pragma unroll
    for (int j = 0; j < TN; ++j)
#pragma unroll
      for (int r = 0; r < 16; ++r) acc[i][j][r] = 0.f;
#define GLOAD(kt) do { const int k_ = (kt) * BK + sch * 8; \
    _Pragma("unroll") for (int i = 0; i < A_CH; ++i) if (BM % RPS == 0 || srow + i * RPS < BM) ra[i] = al.load(m0 + srow + i * RPS, k_); \
    _Pragma("unroll") for (int i = 0; i < B_CH; ++i) { int n_ = n0 + srow + i * RPS; n_ = n_ < nmax ? n_ : nmax; rb[i] = *(const u32x4*)(Bt + (size_t)n_ * ldb + k_); } } while (0)
#define SWRITE(buf, kt) do { char* base_ = lds + (buf) * STAGE; const int k_ = (kt) * BK + sch * 8; \
    _Pragma("unroll") for (int i = 0; i < A_CH; ++i) if (BM % RPS == 0 || srow + i * RPS < BM) *(bf16x8*)(base_ + swz<RB>(srow + i * RPS, sch)) = al.cvt(ra[i], k_, ss[i]); \
    _Pragma("unroll") for (int i = 0; i < B_CH; ++i) *(u32x4*)(base_ + A_BYTES + swz<RB>(srow + i * RPS, sch)) = rb[i]; } while (0)
#define PUBSS() do { \
    _Pragma("unroll") for (int i = 0; i < A_CH; ++i) { float s_ = ss[i]; \
      _Pragma("unroll") for (int o = 1; o < CPR; o <<= 1) s_ += __shfl_xor(s_, o); \
      if (sch == 0 && (BM % RPS == 0 || srow + i * RPS < BM)) rowss[srow + i * RPS] = s_; } \
    __syncthreads(); } while (0)
  const int nk = K / BK;
  GLOAD(0); SWRITE(0, 0); __syncthreads();
#pragma unroll 1
  for (int kt = 0; kt < nk; ++kt) {
    if (kt + 1 < nk) GLOAD(kt + 1);
    if (MIDKT >= 0 && kt == MIDKT) {
      PUBSS();
#pragma unroll
      for (int i = 0; i < TM; ++i)
      { float rs = rsqrtf(rowss[wm * (TM * 32) + i * 32 + r32] * (1.f / 512.f) + EPS); if (midsc) rs *= midsc[wm * (TM * 32) + i * 32 + r32];
#pragma unroll
        for (int j = 0; j < TN; ++j)
#pragma unroll
          for (int r = 0; r < 16; ++r) acc[i][j][r] *= rs; }
    }
    const char* base = lds + (kt & 1) * STAGE;
#pragma unroll
    for (int ks = 0; ks < BK / 16; ++ks) {
      bf16x8 af[TM], bfr[TN];
#pragma unroll
      for (int i = 0; i < TM; ++i) af[i] = *(const bf16x8*)(base + swz<RB>(wm * (TM * 32) + i * 32 + r32, ks * 2 + hi));
#pragma unroll
      for (int j = 0; j < TN; ++j) bfr[j] = *(const bf16x8*)(base + A_BYTES + swz<RB>(wn * (TN * 32) + j * 32 + r32, ks * 2 + hi));
#pragma unroll
      for (int i = 0; i < TM; ++i)
#pragma unroll
        for (int j = 0; j < TN; ++j) acc[i][j] = __builtin_amdgcn_mfma_f32_32x32x16_bf16(bfr[j], af[i], acc[i][j], 0, 0, 0);
    }
    if (kt + 1 < nk) SWRITE((kt + 1) & 1, kt + 1);
    __syncthreads();
  }
  if (MIDKT < 0) PUBSS();
#undef GLOAD
#undef SWRITE
#undef PUBSS
}

__device__ __forceinline__ int row_pos(int m) { return m < RX ? (m & (SEQ - 1)) + NMETA : m - RX; }
__device__ __forceinline__ uint2 pack4(float a, float b, float c, float d) { uint2 w; w.x = cvtpk(a, b); w.y = cvtpk(c, d); return w; }
__device__ __forceinline__ void rope_block(f32x16& v, const float2* rope_pos, int hi) {
#pragma unroll
  for (int g = 0; g < 2; ++g)
#pragma unroll
    for (int e = 0; e < 4; ++e) { const int r = 4 * g + e; const float2 cs = rope_pos[8 * g + 4 * hi + e];
      const float x1 = v[r], x2 = v[r + 8]; v[r] = x1 * cs.x - x2 * cs.y; v[r + 8] = x1 * cs.y + x2 * cs.x; }
}

constexpr int NT_INPROJ = 5 * 256;
__device__ __forceinline__ void inproj_xform(const P& p, f32x16& a, int m, int nb, int hi, float rs) {
#pragma unroll
  for (int r = 0; r < 16; ++r) a[r] *= rs;
  if (nb == 384) rope_block(a, WSP(float2, O_ROPE) + row_pos(m < RT ? m : RT - 1) * 16, hi);
  else if ((nb >= 416 && nb < 928) || nb >= 1440) {
#pragma unroll
    for (int r = 0; r < 16; ++r) a[r] = silu(a[r]); }
}
constexpr int EP_RS = 144;
__device__ __forceinline__ void inproj_rows(const P& p, char* wl, f32x16& a0, f32x16& a1, int mrow0, int nb0, int lane, int r32, int hi) {
  const int m = mrow0 + r32; const float rs = WSP(float, O_RSX)[m < RT ? m : RT - 1];
  inproj_xform(p, a0, m, nb0, hi, rs); inproj_xform(p, a1, m, nb0 + 32, hi, rs);
#pragma unroll
  for (int g = 0; g < 4; ++g) {
    *(uint2*)(wl + r32 * EP_RS + (8 * g + 4 * hi) * 2) = pack4(a0[4 * g], a0[4 * g + 1], a0[4 * g + 2], a0[4 * g + 3]);
    *(uint2*)(wl + r32 * EP_RS + (32 + 8 * g + 4 * hi) * 2) = pack4(a1[4 * g], a1[4 * g + 1], a1[4 * g + 2], a1[4 * g + 3]); }
#pragma unroll
  for (int it = 0; it < 4; ++it) {
    const int row = it * 8 + (lane >> 3), ch = lane & 7, mm = mrow0 + row, n = nb0 + ch * 8;
    const u32x4 v = *(const u32x4*)(wl + row * EP_RS + ch * 16);
    if (n >= DIN || mm >= RT) continue;
    bf16* dst;
    if (n < 256) dst = WSP(bf16, O_QLAT) + (size_t)mm * QL + n;
    else if (n < 384) dst = WSP(bf16, O_KVLAT) + (size_t)mm * KVL + (n - 256);
    else if (n < 416) { const int pos = row_pos(mm), c = n - 384; bf16* kr = WSP(bf16, O_KR);
      if (mm < RX) dst = kr + ((size_t)(mm >> 14) * NKEY + KPAD + pos) * 32 + c;
      else { *(u32x4*)(kr + ((size_t)NKEY + KPAD + pos) * 32 + c) = v; dst = kr + ((size_t)KPAD + pos) * 32 + c; } }
    else if (n < 928) { if (mm >= RX) continue; dst = WSP(bf16, O_AGATE) + (size_t)mm * DA + (n - 416); }
    else if (n < 1440) { const int c = n - 928; dst = WSP(bf16, O_SUG) + ((size_t)(c >> 4) * RP + mm) * GH + (c & 15); }
    else { if (mm >= RX) continue; dst = WSP(bf16, O_SGATE) + (size_t)mm * DS + (n - 1440); }
    *(u32x4*)dst = v;
  }
}
__device__ __forceinline__ void phase_inproj(const P& p, int tile, char* lds) {
  const int rnd = tile >> 8, s = tile & 255, xcd = s & 7, slot = s >> 3;
  const int mt = rnd * 32 + xcd * 4 + (slot >> 3), nt = slot & 7;
  if (mt > 128) return;
  const int m0 = mt * 256, n0 = nt * 256;
  f32x16 acc[4][2]; ALBn al{WSP(bf16, O_XB), LDK, RT - 1};
  gemm_main<256, 256, 64, 2, 4, -1>(lds, al, m0, WSP(bf16, O_WTIN), LDK, n0, DIN - 1, DM, acc);
  const int tid_ = otid(), lane = tid_ & 63, wid = tid_ >> 6, wm = wid >> 2, wn = wid & 3, r32 = lane & 31, hi = lane >> 5;
  const int mw = m0 + wm * 128, nb = n0 + wn * 64; char* wl = lds + wid * (32 * EP_RS);
  inproj_rows(p, wl, acc[0][0], acc[0][1], mw, nb, lane, r32, hi);
  inproj_rows(p, wl, acc[1][0], acc[1][1], mw + 32, nb, lane, r32, hi);
  inproj_rows(p, wl, acc[2][0], acc[2][1], mw + 64, nb, lane, r32, hi);
  inproj_rows(p, wl, acc[3][0], acc[3][1], mw + 96, nb, lane, r32, hi);
  __syncthreads();
}
constexpr int NT_QUP = (RX / 256) * 3, NT_KVUP = (RP / 256) * 4;
__device__ __forceinline__ void qup_epi(const P& p, f32x16 a, int m, int nb, int hi, float rs) {
  const int h = nb / DQK, c0 = nb % DQK, b = m >> 14, ii = m & (SEQ - 1);
#pragma unroll
  for (int r = 0; r < 16; ++r) a[r] *= rs;
  if (c0 == 64) rope_block(a, WSP(float2, O_ROPE) + (ii + NMETA) * 16, hi);
  bf16* dst = WSP(bf16, O_Q) + (((size_t)b * NH + h) * SEQ + ii) * DQK + c0 + 4 * hi;
#pragma unroll
  for (int g = 0; g < 4; ++g) *(uint2*)(dst + 8 * g) = pack4(a[4 * g], a[4 * g + 1], a[4 * g + 2], a[4 * g + 3]);
}
__device__ __forceinline__ void phase_qup(const P& p, int tile, char* lds) {
  const int mt = tile / 3, nt = tile % 3, m0 = mt * 256, n0 = nt * 256;
  f32x16 acc[4][2]; ALB al{WSP(bf16, O_QLAT), QL, RT - 1};
  gemm_main<256, 256, 64, 2, 4, -1>(lds, al, m0, WSP(bf16, O_WTQ), QL, n0, 767, QL, acc);
  const int tid_ = otid(), lane = tid_ & 63, wid = tid_ >> 6, wm = wid >> 2, wn = wid & 3, r32 = lane & 31, hi = lane >> 5;
  const float* rowss = (const float*)(lds + LDS_ROWSS); const int lr = wm * 128 + r32, nb = n0 + wn * 64;
  constexpr float QC = 0.10206207261596577f * 1.4426950408889634f;
#define QROW(i) do { const float rs_ = rsqrtf(rowss[lr + 32 * (i)] * (1.f / QL) + EPS) * QC; qup_epi(p, acc[i][0], m0 + lr + 32 * (i), nb, hi, rs_); qup_epi(p, acc[i][1], m0 + lr + 32 * (i), nb + 32, hi, rs_); } while (0)
  QROW(0); QROW(1); QROW(2); QROW(3);
#undef QROW
  __syncthreads();
}
__device__ __forceinline__ void kvup_epi(const P& p, const f32x16& a, int m, int nb, int hi, float rs) {
  if (m >= RT) return;
  const int h = nb >> 7, c0 = nb & 127; bf16* base = c0 < 64 ? WSP(bf16, O_KN) : WSP(bf16, O_V); const int c = (c0 & 63) + 4 * hi;
#pragma unroll
  for (int g = 0; g < 4; ++g) { const uint2 w = pack4(a[4 * g] * rs, a[4 * g + 1] * rs, a[4 * g + 2] * rs, a[4 * g + 3] * rs);
    if (m < RX) *(uint2*)(base + (((size_t)(m >> 14) * NH + h) * NKEY + KPAD + NMETA + (m & (SEQ - 1))) * 64 + c + 8 * g) = w;
    else { const int jk = KPAD + (m - RX); *(uint2*)(base + ((size_t)h * NKEY + jk) * 64 + c + 8 * g) = w; *(uint2*)(base + (((size_t)NH + h) * NKEY + jk) * 64 + c + 8 * g) = w; } }
}
__device__ __forceinline__ void phase_kvup(const P& p, int tile, char* lds) {
  const int mt = tile >> 2, nt = tile & 3, m0 = mt * 256, n0 = nt * 256;
  f32x16 acc[4][2]; ALB al{WSP(bf16, O_KVLAT), KVL, RT - 1};
  gemm_main<256, 256, 64, 2, 4, -1>(lds, al, m0, WSP(bf16, O_WTKV), KVL, n0, 1023, KVL, acc);
  const int tid_ = otid(), lane = tid_ & 63, wid = tid_ >> 6, wm = wid >> 2, wn = wid & 3, r32 = lane & 31, hi = lane >> 5;
  const float* rowss = (const float*)(lds + LDS_ROWSS); const int lr = wm * 128 + r32, nb = n0 + wn * 64;
#define KVROW(i) do { const float rs_ = rsqrtf(rowss[lr + 32 * (i)] * (1.f / KVL) + EPS); kvup_epi(p, acc[i][0], m0 + lr + 32 * (i), nb, hi, rs_); kvup_epi(p, acc[i][1], m0 + lr + 32 * (i), nb + 32, hi, rs_); } while (0)
  KVROW(0); KVROW(1); KVROW(2); KVROW(3);
#undef KVROW
  __syncthreads();
}
__device__ __forceinline__ float pair_sum(float v) { return v + __shfl_xor(v, 32); }
constexpr int NT_GLU = 512;
__device__ __forceinline__ void glu_epi(const P& p, const f32x16& av, const f32x16& ag, int m, int q, int hi) {
  const float* bg = WSP(float, O_BGLU); const bf16* sg = WSP(bf16, O_SGATE); bf16* yrow = WSP(bf16, O_YSN) + (size_t)m * DS + q * 32; float part = 0.f;
#pragma unroll
  for (int g = 0; g < 4; ++g) { const int cc = 8 * g + 4 * hi; const f32x4v ba = *(const f32x4v*)(bg + q * 64 + cc), bgt = *(const f32x4v*)(bg + q * 64 + 32 + cc);
    const uint2 gw = *(const uint2*)(sg + (size_t)m * DS + q * 32 + cc); const float gt[4] = {bflo(gw.x), bfhi(gw.x), bflo(gw.y), bfhi(gw.y)}; float v[4];
#pragma unroll
    for (int e = 0; e < 4; ++e) { const float a_ = av[4 * g + e] + ba[e], g_ = ag[4 * g + e] + bgt[e]; v[e] = a_ / (1.f + __expf(-g_)) * gt[e]; part += v[e] * v[e]; }
    *(uint2*)(yrow + cc) = pack4(v[0], v[1], v[2], v[3]); }
  part = pair_sum(part);
  if (hi == 0) WSP(float, O_GPART)[(size_t)q * RX + m] = part;
}
__device__ __forceinline__ void phase_glu(const P& p, int tile, char* lds) {
  const int rnd = tile >> 8, s = tile & 255, xcd = s & 7, slot = s >> 3, mt = rnd * 64 + xcd * 8 + (slot >> 2), nt = slot & 3, m0 = mt * 256;
  f32x16 acc[4][2]; ALBn al{WSP(bf16, O_YSG), DS, RX - 1};
  gemm_main<256, 256, 64, 2, 4, -1>(lds, al, m0, WSP(bf16, O_WTGLU), DS, nt * 256, 1023, DS, acc);
  const int tid_ = otid(), lane = tid_ & 63, wid = tid_ >> 6, wm = wid >> 2, wn = wid & 3, r32 = lane & 31, hi = lane >> 5;
  const int m = m0 + wm * 128 + r32, q = nt * 4 + wn;
  glu_epi(p, acc[0][0], acc[0][1], m, q, hi); glu_epi(p, acc[1][0], acc[1][1], m + 32, q, hi);
  glu_epi(p, acc[2][0], acc[2][1], m + 64, q, hi); glu_epi(p, acc[3][0], acc[3][1], m + 96, q, hi);
  __syncthreads();
}
constexpr int NT_OUT = 512;
__device__ __forceinline__ float out_epi(const P& p, const f32x16& a, int m, int nb, int hi, float sc) {
  bf16* yrow = WSP(bf16, O_Y) + (size_t)m * DM + nb + 4 * hi; float part = 0.f;
#pragma unroll
  for (int g = 0; g < 4; ++g) { const float v0 = a[4 * g] * sc, v1 = a[4 * g + 1] * sc, v2 = a[4 * g + 2] * sc, v3 = a[4 * g + 3] * sc;
    part += v0 * v0 + v1 * v1 + v2 * v2 + v3 * v3; *(uint2*)(yrow + 8 * g) = pack4(v0, v1, v2, v3); }
  return part;
}
__device__ __forceinline__ void phase_out(const P& p, int tile, char* lds) {
  const int rnd = tile >> 8, s = tile & 255, xcd = s & 7, slot = s >> 3, mt = rnd * 64 + xcd * 8 + (slot >> 2), nt = slot & 3, m0 = mt * 256;
  float* isc = (float*)(lds + LDS_RED);
  { const int t = otid(); if (t < 256) { const float* gp = WSP(float, O_GPART) + m0 + t; float sq = 0.f;
#pragma unroll
      for (int q = 0; q < 16; ++q) sq += gp[(size_t)q * RX];
      isc[t] = sqrtf(sq * (1.f / DS) + EPS); } }
  __syncthreads();
  f32x16 acc[4][2]; ALOut al{WSP(bf16, O_YA), WSP(bf16, O_YSN)};
  gemm_main<256, 256, 64, 2, 4, 8>(lds, al, m0, WSP(bf16, O_WTOUT), DM, nt * 256, 1023, DM, acc, isc);
  const int tid_ = otid(), lane = tid_ & 63, wid = tid_ >> 6, wm = wid >> 2, wn = wid & 3, r32 = lane & 31, hi = lane >> 5;
  const int lr = wm * 128 + r32, m = m0 + lr, nb = nt * 256 + wn * 64; float* yp = WSP(float, O_YPART) + (size_t)(nt * 4 + wn) * RX;
#define OUT_ROW(i) do { const float sc_ = 1.f / isc[lr + 32 * (i)]; float part_ = out_epi(p, acc[i][0], m + 32 * (i), nb, hi, sc_) + out_epi(p, acc[i][1], m + 32 * (i), nb + 32, hi, sc_); \
    part_ = pair_sum(part_); if (hi == 0) yp[m + 32 * (i)] = part_; } while (0)
  OUT_ROW(0); OUT_ROW(1); OUT_ROW(2); OUT_ROW(3);
#undef OUT_ROW
  __syncthreads();
}
__device__ __forceinline__ void phase_final(const P& p) {
  const int t = threadIdx.x, rsub = t >> 7, c = (t & 127) * 8; const float* yp = WSP(float, O_YPART);
  const f32x4v w0 = *(const f32x4v*)(p.post_w + c), w1 = *(const f32x4v*)(p.post_w + c + 4);
  for (int row = blockIdx.x * 4 + rsub; row < RX; row += gridDim.x * 4) {
    float sq = 0.f;
#pragma unroll
    for (int q = 0; q < 16; ++q) sq += yp[(size_t)q * RX + row];
    const float rs = rsqrtf(sq * (1.f / DM) + EPS);
    const u32x4 yv = *(const u32x4*)(WSP(bf16, O_Y) + (size_t)row * DM + c);
    const f32x4v x0 = *(const f32x4v*)(p.x + (size_t)row * DM + c), x1 = *(const f32x4v*)(p.x + (size_t)row * DM + c + 4);
    f32x4v o0, o1;
    o0[0] = x0[0] + bflo(yv[0]) * rs * w0[0]; o0[1] = x0[1] + bfhi(yv[0]) * rs * w0[1]; o0[2] = x0[2] + bflo(yv[1]) * rs * w0[2]; o0[3] = x0[3] + bfhi(yv[1]) * rs * w0[3];
    o1[0] = x1[0] + bflo(yv[2]) * rs * w1[0]; o1[1] = x1[1] + bfhi(yv[2]) * rs * w1[1]; o1[2] = x1[2] + bflo(yv[3]) * rs * w1[2]; o1[3] = x1[3] + bfhi(yv[3]) * rs * w1[3];
    *(f32x4v*)(p.out + (size_t)row * DM + c) = o0; *(f32x4v*)(p.out + (size_t)row * DM + c + 4) = o1;
  }
}

using s16x4 = __attribute__((ext_vector_type(4))) short;
constexpr float ATT_SCALE = 0.10206207261596577f;
constexpr float ATT_THR = 8.f;
constexpr int A_SHM_V = 8192, A_SHM_KN = 8192, A_SHM_KR = 4096;
constexpr int A_OFF_V = 0, A_OFF_KN = 2 * A_SHM_V, A_OFF_KR = A_OFF_KN + 2 * A_SHM_KN, A_OFF_WS = A_OFF_KR + 2 * A_SHM_KR;
#define SBAR() __builtin_amdgcn_sched_barrier(0)
__device__ __forceinline__ unsigned cvtpkv(float lo, float hi) { unsigned r; asm volatile("v_cvt_pk_bf16_f32 %0, %1, %2" : "=v"(r) : "v"(lo), "v"(hi)); return r; }
constexpr float ATT_THR2 = 60.f;
__device__ __forceinline__ float rowmaxSM(const f32x16& p0, const f32x16& p1) {
  float pmax = p0[0];
#pragma unroll
  for (int r = 1; r < 16; ++r) pmax = fmaxf(pmax, p0[r]);
#pragma unroll
  for (int r = 0; r < 16; ++r) pmax = fmaxf(pmax, p1[r]);
  auto rr = __builtin_amdgcn_permlane32_swap(__float_as_uint(pmax), __float_as_uint(pmax), false, false);
  return fmaxf(__uint_as_float(rr[0]), __uint_as_float(rr[1]));
}
__device__ __forceinline__ void decideSM(f32x16& p0, f32x16& p1, float pmax, float& m_reg, float& alpha, bool& zref) {
  if (__builtin_expect(__all(pmax <= ATT_THR2), 1)) { alpha = 1.f; }
  else { const float delta = fmaxf(pmax, 0.f); alpha = __builtin_amdgcn_exp2f(-delta); m_reg += delta; zref = false;
#pragma unroll
    for (int r = 0; r < 16; ++r) { p0[r] -= delta; p1[r] -= delta; } }
#pragma unroll
  for (int r = 0; r < 16; ++r) p0[r] = __builtin_amdgcn_exp2f(p0[r]);
}
__device__ __forceinline__ void firstSM(f32x16& p0, f32x16& p1, float pmax, float& m_reg, float& alpha, bool& zref) {
  alpha = 1.f;
  if (!__all(fabsf(pmax) <= ATT_THR2)) { const float delta = fabsf(pmax) <= ATT_THR2 ? 0.f : pmax; m_reg = delta; zref = false;
#pragma unroll
    for (int r = 0; r < 16; ++r) { p0[r] -= delta; p1[r] -= delta; } }
#pragma unroll
  for (int r = 0; r < 16; ++r) p0[r] = __builtin_amdgcn_exp2f(p0[r]);
}
#define SCHEDPAT() do { _Pragma("unroll") for (int i_ = 0; i_ < 10; ++i_) { __builtin_amdgcn_sched_group_barrier(0x008, 2, 0); __builtin_amdgcn_sched_group_barrier(0x100, 4, 0); __builtin_amdgcn_sched_group_barrier(0x002, 9, 0); } } while (0)
template <bool HALF_SUM = false> __device__ __forceinline__ void finishSM(f32x16& p0, f32x16& p1, float alpha, float& l_reg, bf16x8& pa0, bf16x8& pa1, bf16x8& pa2, bf16x8& pa3) {
#pragma unroll
  for (int r = 0; r < 16; ++r) p1[r] = __builtin_amdgcn_exp2f(p1[r]);
  float ps = 0;
#pragma unroll
  for (int r = 0; r < 16; ++r) ps += p0[r];
#pragma unroll
  for (int r = 0; r < 16; ++r) ps += p1[r];
  if (!HALF_SUM) { auto rr = __builtin_amdgcn_permlane32_swap(__float_as_uint(ps), __float_as_uint(ps), false, false);
    ps = __uint_as_float(rr[0]) + __uint_as_float(rr[1]); }
  l_reg = l_reg * alpha + ps;
#define PK4(Pv, BASE, OUT) do { u32x4 w = {cvtpkv(Pv[BASE + 0], Pv[BASE + 1]), cvtpkv(Pv[BASE + 2], Pv[BASE + 3]), cvtpkv(Pv[BASE + 4], Pv[BASE + 5]), cvtpkv(Pv[BASE + 6], Pv[BASE + 7])}; \
    OUT = (bf16x8)w; } while (0)
  PK4(p0, 0, pa0); PK4(p0, 8, pa1); PK4(p1, 0, pa2); PK4(p1, 8, pa3);
#undef PK4
}
__device__ __forceinline__ void qkt(f32x16& p0, f32x16& p1, const char* Kn, const char* Kr, const bf16x8* qr, int r32, int hi, float init) {
#pragma unroll
  for (int r = 0; r < 16; ++r) { p0[r] = init; p1[r] = init; }
#pragma unroll
  for (int d0 = 0; d0 < 4; ++d0) {
    bf16x8 b0 = *(const bf16x8*)(Kn + swz<128>(r32, d0 * 2 + hi));
    bf16x8 b1 = *(const bf16x8*)(Kn + swz<128>(32 + r32, d0 * 2 + hi));
    p0 = __builtin_amdgcn_mfma_f32_32x32x16_bf16(b0, qr[d0], p0, 0, 0, 0);
    p1 = __builtin_amdgcn_mfma_f32_32x32x16_bf16(b1, qr[d0], p1, 0, 0, 0); }
#pragma unroll
  for (int d0 = 0; d0 < 2; ++d0) {
    bf16x8 b0 = *(const bf16x8*)(Kr + swz<64>(r32, d0 * 2 + hi));
    bf16x8 b1 = *(const bf16x8*)(Kr + swz<64>(32 + r32, d0 * 2 + hi));
    p0 = __builtin_amdgcn_mfma_f32_32x32x16_bf16(b0, qr[4 + d0], p0, 0, 0, 0);
    p1 = __builtin_amdgcn_mfma_f32_32x32x16_bf16(b1, qr[4 + d0], p1, 0, 0, 0); }
}
__device__ __forceinline__ int v_st(int k, int c) { const int kk = k;     return ((kk >> 3) * 2 + (c >> 5)) * 512 + ((kk & 7) * 32 + (c & 31)) * 2; }
__device__ __forceinline__ int v_rd_base(int lane) { return ((lane & 3) << 3) | (((lane >> 2) & 3) << 6) | (((lane >> 4) & 1) << 5) | (((lane >> 5) & 1) << 8); }
constexpr int v_rd_off(int d0, int ks, int half) { return d0 * 512 + ks * 2048 + half * 1024; }
template <int OFF> __device__ __forceinline__ s16x4 tr_read(int vb) {
  return __builtin_amdgcn_ds_read_tr16_b64_v4i16((__attribute__((address_space(3))) s16x4*)(uintptr_t)(unsigned)(vb + OFF));
}
template <int D0> __device__ __forceinline__ void pv_one(f32x16& od, int vb, bf16x8 pa0, bf16x8 pa1, bf16x8 pa2, bf16x8 pa3) {
  const s16x4 l0 = tr_read<v_rd_off(D0, 0, 0)>(vb), h0 = tr_read<v_rd_off(D0, 0, 1)>(vb), l1 = tr_read<v_rd_off(D0, 1, 0)>(vb), h1 = tr_read<v_rd_off(D0, 1, 1)>(vb);
  const s16x4 l2 = tr_read<v_rd_off(D0, 2, 0)>(vb), h2 = tr_read<v_rd_off(D0, 2, 1)>(vb), l3 = tr_read<v_rd_off(D0, 3, 0)>(vb), h3 = tr_read<v_rd_off(D0, 3, 1)>(vb);
#define PKV(L, H) (bf16x8){L[0], L[1], L[2], L[3], H[0], H[1], H[2], H[3]}
  od = __builtin_amdgcn_mfma_f32_32x32x16_bf16(PKV(l0, h0), pa0, od, 0, 0, 0);
  od = __builtin_amdgcn_mfma_f32_32x32x16_bf16(PKV(l1, h1), pa1, od, 0, 0, 0);
  od = __builtin_amdgcn_mfma_f32_32x32x16_bf16(PKV(l2, h2), pa2, od, 0, 0, 0);
  od = __builtin_amdgcn_mfma_f32_32x32x16_bf16(PKV(l3, h3), pa3, od, 0, 0, 0);
#undef PKV
}
constexpr int NT_ATTN = NB * NH * (SEQ / 256);
constexpr int ATT_NT = NKEY / 64;
#ifndef ATT_FORCE_FALLBACK
#define ATT_FORCE_FALLBACK 0
#endif
template <bool FAST> __device__ __forceinline__ void attn_item(const P& p, int item, char* lds) {
  const int rnd = item >> 8, s = item & 255, xcd = s & 7, idx = s >> 3;
  const int bh = rnd * 4 + (xcd >> 1), qblk = (xcd & 1) * 32 + idx, b = bh >> 3, h = bh & 7, i0 = qblk * 256;
  const int tid = otid(), wid = tid >> 6, lane = tid & 63, r32 = lane & 31, hi = lane >> 5;
  const bf16* Qb = WSP(bf16, O_Q) + ((size_t)bh * SEQ + i0) * DQK;
  const bf16* Knh = WSP(bf16, O_KN) + (size_t)bh * NKEY * 64; const bf16* Vh = WSP(bf16, O_V) + (size_t)bh * NKEY * 64;
  const bf16* Krb = WSP(bf16, O_KR) + (size_t)b * NKEY * 32;
  char* V_lds = lds + A_OFF_V; char* Kn_lds = lds + A_OFF_KN; char* Kr_lds = lds + A_OFF_KR;
  volatile unsigned* redo = (volatile unsigned*)(lds + A_OFF_WS);
  if (FAST && tid == 0) *redo = 0u;
  float m_reg = 0.f, l_reg = 0; bool zref = true; f32x16 o[2]; bf16x8 qr[6];
#pragma unroll
  for (int r = 0; r < 16; ++r) { o[0][r] = 0.f; o[1][r] = 0.f; }
  const bf16* Qw = Qb + (size_t)(wid * 32 + r32) * DQK + hi * 8;
#pragma unroll
  for (int d0 = 0; d0 < 6; ++d0) qr[d0] = *(const bf16x8*)(Qw + d0 * 16);
  const int sr = tid >> 3, sc = tid & 7;
  const int vst = v_st(sr, sc * 8), knst = swz<128>(sr, sc), krst = swz<64>(sr, sc >> 1) + (sc & 1) * 8;
  const int vb0 = (int)(uintptr_t)V_lds + v_rd_base(lane);
  struct { u32x4 v, kn; uint2 kr; } st_[2];
#define SLOAD(i, k0) do { st_[i].v = *(const u32x4*)(Vh + (size_t)((k0) + sr) * 64 + sc * 8); st_[i].kn = *(const u32x4*)(Knh + (size_t)((k0) + sr) * 64 + sc * 8); \
    st_[i].kr = *(const uint2*)(Krb + (size_t)((k0) + sr) * 32 + sc * 4); } while (0)
#define SWRITE(bq, i) do { *(u32x4*)(V_lds + (bq) * A_SHM_V + vst) = st_[i].v; *(u32x4*)(Kn_lds + (bq) * A_SHM_KN + knst) = st_[i].kn; \
    *(uint2*)(Kr_lds + (bq) * A_SHM_KR + krst) = st_[i].kr; } while (0)
#define SWAIT() asm volatile("s_waitcnt vmcnt(3)" ::: "memory")
#define RESC(a) do { if (__any((a) < 1.f)) { _Pragma("unroll") for (int d = 0; d < 2; ++d) _Pragma("unroll") for (int r = 0; r < 16; ++r) o[d][r] *= (a); } } while (0)
#define PV(vbx) do { pv_one<0>(o[0], (vbx), pa0, pa1, pa2, pa3); pv_one<1>(o[1], (vbx), pa0, pa1, pa2, pa3); } while (0)
  f32x16 pA0, pA1, pB0, pB1; float alA, alB; bf16x8 pa0, pa1, pa2, pa3; constexpr int NT = ATT_NT;
  constexpr int SE = 0, SO = 1;
  if (wid >= 4) __builtin_amdgcn_s_setprio(1);
  SLOAD(SE, 0); asm volatile("s_waitcnt vmcnt(0)" ::: "memory"); SWRITE(0, SE); __syncthreads();
  qkt(pA0, pA1, Kn_lds, Kr_lds, qr, r32, hi, 0.f);
#pragma unroll
  for (int r = 0; r < 16; ++r) pA0[r] = -1e30f;
#pragma unroll
  for (int r = 0; r < 8; ++r) pA1[r] = -1e30f;
  { const float pm_ = rowmaxSM(pA0, pA1); firstSM(pA0, pA1, pm_, m_reg, alA, zref); }
  bool bad = FAST && !zref;
  SLOAD(SO, 64); SLOAD(SE, 128);
  SWAIT(); SWRITE(1, SO); __syncthreads();
  for (int j = 1; j + 1 < NT; j += 2) {
    if (FAST || zref) qkt(pB0, pB1, Kn_lds + A_SHM_KN, Kr_lds + A_SHM_KR, qr, r32, hi, 0.f); else qkt(pB0, pB1, Kn_lds + A_SHM_KN, Kr_lds + A_SHM_KR, qr, r32, hi, -m_reg);
    finishSM<FAST>(pA0, pA1, alA, l_reg, pa0, pa1, pa2, pa3);
    SLOAD(SO, (j + 2 < NT ? j + 2 : NT - 1) * 64);
    PV(vb0);
    if (FAST) { SCHEDPAT(); alB = 1.f; _Pragma("unroll") for (int r = 0; r < 16; ++r) pB0[r] = __builtin_amdgcn_exp2f(pB0[r]); }
    else { const float pm_ = rowmaxSM(pB0, pB1); SCHEDPAT(); decideSM(pB0, pB1, pm_, m_reg, alB, zref); }
    __syncthreads(); SWAIT(); SWRITE(0, SE);
    if (!FAST) RESC(alB);
    __syncthreads();
    if (FAST || zref) qkt(pA0, pA1, Kn_lds, Kr_lds, qr, r32, hi, 0.f); else qkt(pA0, pA1, Kn_lds, Kr_lds, qr, r32, hi, -m_reg);
    finishSM<FAST>(pB0, pB1, alB, l_reg, pa0, pa1, pa2, pa3);
    SLOAD(SE, (j + 3 < NT ? j + 3 : NT - 1) * 64);
    PV(vb0 + A_SHM_V);
    if (FAST) { SCHEDPAT(); alA = 1.f; _Pragma("unroll") for (int r = 0; r < 16; ++r) pA0[r] = __builtin_amdgcn_exp2f(pA0[r]); }
    else { const float pm_ = rowmaxSM(pA0, pA1); SCHEDPAT(); decideSM(pA0, pA1, pm_, m_reg, alA, zref); }
    __syncthreads(); SWAIT(); SWRITE(1, SO);
    if (!FAST) RESC(alA);
    __syncthreads();
  }
  __builtin_amdgcn_s_setprio(0);
  finishSM<FAST>(pA0, pA1, alA, l_reg, pa0, pa1, pa2, pa3); SBAR();
  PV(vb0);
  if (FAST) l_reg += __shfl_xor(l_reg, 32);
  if (FAST) { float chk = l_reg;
#pragma unroll
    for (int r = 0; r < 16; ++r) chk += fabsf(o[0][r]) + fabsf(o[1][r]);
    bad = bad || !(chk < 3.0e38f) || !(l_reg > 0.f) ; if (ATT_FORCE_FALLBACK) { int one_ = 1; asm volatile("" : "+v"(one_)); bad = bad || (one_ != 0); }
    if (__any(bad) && lane == 0) *redo = 1u; }
  { const float rl = __builtin_amdgcn_rcpf(l_reg); const size_t rowoff = (size_t)(b * SEQ + i0 + wid * 32 + r32) * DA + h * 64 + 4 * hi;
    const bf16* gate = WSP(bf16, O_AGATE) + rowoff; bf16* ya = WSP(bf16, O_YA) + rowoff;
#pragma unroll
    for (int d0 = 0; d0 < 2; ++d0)
#pragma unroll
      for (int g = 0; g < 4; ++g) { const uint2 gw = *(const uint2*)(gate + d0 * 32 + 8 * g);
        *(uint2*)(ya + d0 * 32 + 8 * g) = pack4(o[d0][4 * g] * rl * bflo(gw.x), o[d0][4 * g + 1] * rl * bfhi(gw.x), o[d0][4 * g + 2] * rl * bflo(gw.y), o[d0][4 * g + 3] * rl * bfhi(gw.y)); } }
  __syncthreads();
  bool again = false; if (FAST) { again = (*redo != 0u); __syncthreads(); }
#undef SLOAD
#undef SWRITE
#undef SWAIT
#undef RESC
#undef PV
  if (FAST) { if (again) attn_item<false>(p, item, lds); }
}


__device__ __forceinline__ void build_tables_p1(const P& p) {
  const size_t gid = blockIdx.x * 512ull + threadIdx.x, gsz = gridDim.x * 512ull;
  const float2* pw = WSP(float2, O_PW); const float2* bbar = WSP(float2, O_BBAR); float* Kt = WSP(float, O_KT); bf16* WS = WSP(bf16, O_WS);
  for (size_t i = gid; i < (size_t)2 * 32 * 16 * 256; i += gsz) { const int h = i & 15, hp = (i >> 4) & 15, d = (i >> 8) & 15, dg = i >> 12;
    float s = 0.f;
#pragma unroll 8
    for (int pp = 0; pp < 64; ++pp) { const float2 pv = pw[(dg * 64 + pp) * 17 + d]; const float cr = p.c_re[(dg * 16 + hp) * 64 + pp], ci = p.c_im[(dg * 16 + hp) * 64 + pp];
      const float2 bb = bbar[(dg * 64 + pp) * 16 + h]; const float xr = cr * pv.x - ci * pv.y, xi = cr * pv.y + ci * pv.x; s += xr * bb.x - xi * bb.y; }
    Kt[i] = s; }
  for (size_t i8 = gid; i8 < (size_t)32 * 256 * 256 / 8; i8 += gsz) { const size_t i = i8 * 8; const int k = i & 255, n = (i >> 8) & 255, g = i >> 16; const int s = k >> 4, h = k & 15, dirS = n >> 7, pp = (n >> 1) & 63, ri = n & 1;
    const int dg = dirS * 32 + g, e = dirS ? s : 15 - s; const float2 pv = pw[(dg * 64 + pp) * 17 + e]; const float2* bb = bbar + (dg * 64 + pp) * 16 + h; float v[8];
#pragma unroll
    for (int q = 0; q < 8; ++q) { const float2 b_ = bb[q]; v[q] = ri ? (pv.x * b_.y + pv.y * b_.x) : (pv.x * b_.x - pv.y * b_.y); }
    u32x4 w = {cvtpk(v[0], v[1]), cvtpk(v[2], v[3]), cvtpk(v[4], v[5]), cvtpk(v[6], v[7])}; *(u32x4*)(WS + i) = w; }
}
__device__ __forceinline__ void build_tables_p2(const P& p) {
  const size_t gid = blockIdx.x * 512ull + threadIdx.x, gsz = gridDim.x * 512ull;
  const float2* pw = WSP(float2, O_PW); const float* Kt = WSP(float, O_KT); bf16* Msg = WSP(bf16, O_MSG);
  for (size_t i8 = gid; i8 < (size_t)32 * 256 * 512 / 8; i8 += gsz) { const size_t i = i8 * 8; const int k = i & 511, n = (i >> 9) & 255, g = i >> 17; const int t = n >> 4, hp = n & 15; float v[8];
    if (k < 256) { const int s = k >> 4, h = k & 15, o = hp * 16 + h;
      if (s != t) { const float* kt = (s < t) ? Kt + ((size_t)g * 16 + (t - s)) * 256 + o : Kt + ((size_t)(32 + g) * 16 + (s - t)) * 256 + o;
        const f32x4v a = *(const f32x4v*)kt, b = *(const f32x4v*)(kt + 4);
        v[0] = a[0]; v[1] = a[1]; v[2] = a[2]; v[3] = a[3]; v[4] = b[0]; v[5] = b[1]; v[6] = b[2]; v[7] = b[3]; }
      else { const float* k0 = Kt + ((size_t)g * 16) * 256 + o; const float* k1 = Kt + ((size_t)(32 + g) * 16) * 256 + o;
        const f32x4v a = *(const f32x4v*)k0, b = *(const f32x4v*)(k0 + 4), c = *(const f32x4v*)k1, d = *(const f32x4v*)(k1 + 4);
        v[0] = a[0] + c[0]; v[1] = a[1] + c[1]; v[2] = a[2] + c[2]; v[3] = a[3] + c[3]; v[4] = b[0] + d[0]; v[5] = b[1] + d[1]; v[6] = b[2] + d[2]; v[7] = b[3] + d[3]; }
    } else { const int kk = k - 256, dirX = kk >> 7, pp0 = (kk >> 1) & 63, dg = dirX * 32 + g, e = dirX ? 16 - t : t + 1;
#pragma unroll
      for (int q = 0; q < 4; ++q) { const int pp = pp0 + q; const float2 pv = pw[(dg * 64 + pp) * 17 + e]; const float cr = p.c_re[(dg * 16 + hp) * 64 + pp], ci = p.c_im[(dg * 16 + hp) * 64 + pp];
        v[2 * q] = cr * pv.x - ci * pv.y; v[2 * q + 1] = -(cr * pv.y + ci * pv.x); } }
    u32x4 w = {cvtpk(v[0], v[1]), cvtpk(v[2], v[3]), cvtpk(v[4], v[5]), cvtpk(v[6], v[7])}; *(u32x4*)(Msg + i) = w; }
}
constexpr int NT_SSMS = 256, NT_SSMY = 512;
__device__ __forceinline__ void phase_ssmS(const P& p, int tile, char* lds) {
  const int g = tile >> 3, mt = tile & 7, m0 = mt * 256;
  f32x16 acc[4][2]; ALBn al{WSP(bf16, O_SUG) + (size_t)g * RP * GH, 256, 2047};
  gemm_main<256, 256, 64, 2, 4, -1>(lds, al, m0, WSP(bf16, O_WS) + (size_t)g * 65536, 256, 0, 255, 256, acc);
  const int tid_ = otid(), lane = tid_ & 63, wid = tid_ >> 6, wm = wid >> 2, wn = wid & 3, r32 = lane & 31, hi = lane >> 5;
  float* S = WSP(float, O_S) + (size_t)g * 2048 * 256;
#pragma unroll
  for (int i = 0; i < 4; ++i)
#pragma unroll
    for (int j = 0; j < 2; ++j)
#pragma unroll
      for (int q = 0; q < 4; ++q) { f32x4v t4 = {acc[i][j][4 * q], acc[i][j][4 * q + 1], acc[i][j][4 * q + 2], acc[i][j][4 * q + 3]};
        *(f32x4v*)(S + (size_t)(m0 + wm * 128 + i * 32 + r32) * 256 + wn * 64 + j * 32 + 8 * q + 4 * hi) = t4; }
  __syncthreads();
}
struct ALU3 { const bf16* u; const bf16* xa; using Raw = u32x4;
  __device__ __forceinline__ Raw load(int m, int k) const { return *(const u32x4*)(k < 256 ? u + (size_t)m * 256 + k : xa + (size_t)m * 256 + (k - 256)); }
  __device__ __forceinline__ bf16x8 cvt(const Raw& v, int k, float& ss) const { return (bf16x8)v; } };
__device__ __forceinline__ void phase_ssmY(const P& p, int tile, char* lds) {
  const int g = tile >> 4, mt = (tile >> 1) & 7, nt = tile & 1, m0 = mt * 256, n0 = nt * 128;
  const bf16* ug = WSP(bf16, O_SUG) + (size_t)g * RP * GH;
  f32x16 acc[2][2]; ALU3 al{ug, WSP(bf16, O_XA) + (size_t)g * 2048 * 256};
  gemm_main<256, 128, 64, 4, 2, -1>(lds, al, m0, WSP(bf16, O_MSG) + (size_t)g * 256 * 512, 512, n0, 255, 512, acc);
  const int tid_ = otid(), lane = tid_ & 63, wid = tid_ >> 6, wm = wid >> 1, wn = wid & 1, r32 = lane & 31, hi = lane >> 5;
  bf16* ysg = WSP(bf16, O_YSG);
#pragma unroll
  for (int i = 0; i < 2; ++i)
#pragma unroll
    for (int j = 0; j < 2; ++j) { const int m = m0 + wm * 64 + i * 32 + r32;
#pragma unroll
      for (int q = 0; q < 4; ++q) { const int n = n0 + wn * 64 + j * 32 + 8 * q + 4 * hi, t = n >> 4, hp = n & 15;
        const f32x4v dd = *(const f32x4v*)(p.ssm_d + g * 16 + hp); const uint2 uw = *(const uint2*)(ug + (size_t)m * 256 + n);
        const float y0 = acc[i][j][4 * q] + dd[0] * bflo(uw.x), y1 = acc[i][j][4 * q + 1] + dd[1] * bfhi(uw.x), y2 = acc[i][j][4 * q + 2] + dd[2] * bflo(uw.y), y3 = acc[i][j][4 * q + 3] + dd[3] * bfhi(uw.y);
        *(uint2*)(ysg + ((size_t)m * 16 + t) * DS + g * 16 + hp) = pack4(gelu_tanh(y0), gelu_tanh(y1), gelu_tanh(y2), gelu_tanh(y3)); } }
  __syncthreads();
}
__device__ __forceinline__ float2 cmul(float2 a, float2 b) { return make_float2(a.x * b.x - a.y * b.y, a.x * b.y + a.y * b.x); }
__device__ __forceinline__ float2 cfma(float2 a, float2 x, float2 s) { return make_float2(a.x * x.x - a.y * x.y + s.x, a.x * x.y + a.y * x.x + s.y); }
__device__ __forceinline__ void phase_carry1(const P& p) {
  const int nthr = 2 * 32 * 2 * 32 * 64; const float2* pw = WSP(float2, O_PW); float2* E = WSP(float2, O_E);
  for (int idx = blockIdx.x * 512 + threadIdx.x; idx < nthr; idx += gridDim.x * 512) {
    const int pp = idx & 63, sc = (idx >> 6) & 31, dir = (idx >> 11) & 1, g = (idx >> 12) & 31, b = idx >> 17;
    const float2 a16 = pw[((dir * 32 + g) * 64 + pp) * 17 + 16];
    const float* S = WSP(float, O_S) + ((size_t)g * 2048 + b * 1024) * 256 + dir * 128 + pp * 2; float2 X = make_float2(0.f, 0.f);
    for (int q = 0; q < 32; ++q) { const int c = sc * 32 + (dir ? 31 - q : q); const float2 s = *(const float2*)(S + (size_t)c * 256); X = cfma(a16, X, s); }
    E[idx] = X; }
}
__device__ __forceinline__ void phase_carry2(const P& p) {
  const int nthr = 2 * 32 * 2 * 32 * 64; const float2* pw = WSP(float2, O_PW); const float2* E = WSP(float2, O_E); const float2* bbar = WSP(float2, O_BBAR);
  for (int idx = blockIdx.x * 512 + threadIdx.x; idx < nthr; idx += gridDim.x * 512) {
    const int pp = idx & 63, sc = (idx >> 6) & 31, dir = (idx >> 11) & 1, g = (idx >> 12) & 31, b = idx >> 17;
    const int dgp = (dir * 32 + g) * 64 + pp; const float2 a16 = pw[dgp * 17 + 16];
    float2 a512 = a16;
#pragma unroll
    for (int q = 0; q < 5; ++q) a512 = cmul(a512, a512);
    float2 X = make_float2(0.f, 0.f); const float2* Eb = E + (idx & ~(31 << 6) & ~63) + pp;
    if (dir == 0) {
      const bf16* um = WSP(bf16, O_SUG) + ((size_t)g * RP + RX) * GH;
      for (int s = 0; s < 16; ++s) { float2 bu = make_float2(0.f, 0.f);
        for (int h = 0; h < 16; ++h) { const float u = bf2f(um[s * 16 + h]); const float2 bb = bbar[dgp * 16 + h]; bu.x += bb.x * u; bu.y += bb.y * u; }
        X = cfma(pw[dgp * 17 + 1], X, bu); }
      for (int j = 0; j < sc; ++j) X = cfma(a512, X, Eb[j * 64]);
    } else {
      for (int j = 31; j > sc; --j) X = cfma(a512, X, Eb[j * 64]);
    }
    const float* S = WSP(float, O_S) + ((size_t)g * 2048 + b * 1024) * 256 + dir * 128 + pp * 2;
    bf16* XA = WSP(bf16, O_XA) + ((size_t)g * 2048 + b * 1024) * 256 + dir * 128 + pp * 2;
    for (int q = 0; q < 32; ++q) { const int c = sc * 32 + (dir ? 31 - q : q);
      *(unsigned*)(XA + (size_t)c * 256) = cvtpk(X.x, X.y);
      const float2 s = *(const float2*)(S + (size_t)c * 256); X = cfma(a16, X, s); }
  }
}


#define XB_TMO      128
#define XB_XCNT(j)  (256  + 64 * (j))
#define XB_XSUB(j)  (1280 + 64 * (j))
#define XB_XGEN(j)  (2304 + 64 * (j))
#define XB_TOP      3328
#define XB_TOPGEN   3392
#define XCD_BAR_WORDS 3456
#define XB_SPIN_CAP (1u << 22)
#define LAS __attribute__((address_space(3)))
__device__ __forceinline__ unsigned xb_ld(unsigned* p)              { return __hip_atomic_load(p, __ATOMIC_RELAXED, __HIP_MEMORY_SCOPE_AGENT); }
__device__ __forceinline__ unsigned xb_add(unsigned* p, unsigned v) { return __hip_atomic_fetch_add(p, v, __ATOMIC_RELAXED, __HIP_MEMORY_SCOPE_AGENT); }
__device__ __forceinline__ unsigned xb_xcc_id() { return (unsigned)__builtin_amdgcn_s_getreg((3 << 11) | 20) & 0xFu; }
#define XB_SPIN(cond, bar) do { unsigned _sp = 0; while (cond) { __builtin_amdgcn_s_sleep(1); \
    if ((++_sp & 255u) == 0u) { if (xb_ld(&(bar)[XB_TMO])) break; if (_sp > XB_SPIN_CAP) { atomicAdd(&(bar)[XB_TMO], 1u); break; } } } } while (0)
struct XcdBarrier { unsigned* bar; unsigned x; volatile LAS unsigned* st; };
__device__ __forceinline__ XcdBarrier xcd_barrier_post(unsigned* bar, volatile LAS unsigned* st) {
  XcdBarrier b; b.bar = bar; b.x = xb_xcc_id(); b.st = st;
  if (threadIdx.x == 0) (void)xb_add(&bar[XB_XCNT(b.x)], 1u);
  return b;
}
__device__ __forceinline__ void xcd_barrier_complete(unsigned* bar, unsigned x, unsigned& nloc, unsigned& nx) {
  const unsigned G = gridDim.x * gridDim.y * gridDim.z; unsigned sum, cnt, mine, sp = 0u;
  for (;;) {
    sum = 0u; cnt = 0u; mine = 0u;
#pragma unroll
    for (unsigned j = 0; j < 16; ++j) { const unsigned c = xb_ld(&bar[XB_XCNT(j)]); sum += c; cnt += (c > 0u) ? 1u : 0u; mine = (j == x) ? c : mine; }
    if (sum == G) break;
    __builtin_amdgcn_s_sleep(1);
    if ((++sp & 255u) == 0u) { if (xb_ld(&bar[XB_TMO])) break; if (sp > XB_SPIN_CAP) { atomicAdd(&bar[XB_TMO], 1u); break; } }
  }
  nloc = mine > 0u ? mine : 1u; nx = cnt > 0u ? cnt : 1u;
}
__device__ __forceinline__ void xcd_barrier(const XcdBarrier& b) {
  asm volatile("s_waitcnt vmcnt(0)" ::: "memory");
  __syncthreads();
  if (threadIdx.x == 0) {
    unsigned* bar = b.bar;
    __builtin_amdgcn_s_waitcnt(0);
    unsigned nloc = b.st[0], nx = b.st[1];
    if (nloc == 0u) { xcd_barrier_complete(bar, b.x, nloc, nx); b.st[0] = nloc; b.st[1] = nx; }
    const unsigned old = xb_add(&bar[XB_XSUB(b.x)], 1u);
    const unsigned gen = old / nloc;
    if (old + 1u == (gen + 1u) * nloc) {
      __builtin_amdgcn_fence(__ATOMIC_RELEASE, "agent");
      asm volatile("s_waitcnt vmcnt(0)" ::: "memory");
      const unsigned og = xb_add(&bar[XB_TOP], 1u);
      const unsigned tg = og / nx;
      if (og + 1u == (tg + 1u) * nx) xb_add(&bar[XB_TOPGEN], 1u);
      else XB_SPIN(xb_ld(&bar[XB_TOPGEN]) == tg, bar);
      __builtin_amdgcn_fence(__ATOMIC_ACQUIRE, "agent");
      xb_add(&bar[XB_XGEN(b.x)], 1u);
      asm volatile("s_waitcnt vmcnt(0)" ::: "memory");
    } else {
      XB_SPIN(xb_ld(&bar[XB_XGEN(b.x)]) == gen, bar);
      __builtin_amdgcn_fence(__ATOMIC_ACQUIRE, "agent");
      asm volatile("s_waitcnt vmcnt(0)" ::: "memory");
    }
  }
  __syncthreads();
}

__global__ void __launch_bounds__(512) k_mega(P p) {
  __shared__ __attribute__((aligned(16))) char lds[LDS_BYTES];
  cg::grid_group grid = cg::this_grid();
  __shared__ uint4 xb_words;
  if (threadIdx.x == 0) xb_words = make_uint4(0u, 0u, 0u, 0u);
  __syncthreads();
  XcdBarrier xbar = xcd_barrier_post(WSP(unsigned, O_BAR), (volatile LAS unsigned*)&xb_words);
#define GSYNC() do { for (int q_ = 0; q_ < REP_SYNC; ++q_) xcd_barrier(xbar); } while (0)
  if (p.ws == nullptr) grid.sync();
  prep_all(p, lds);
  xcd_barrier(xbar);
  build_tables_p1(p);
  for (int rep = 0; rep < REP_INPROJ; ++rep) for (int t = blockIdx.x; t < NT_INPROJ; t += gridDim.x) phase_inproj(p, t, lds);
  GSYNC();
  build_tables_p2(p);
  for (int rep = 0; rep < REP_P2; ++rep)
  for (int t = blockIdx.x; t < NT_QUP + NT_KVUP + NT_SSMS; t += gridDim.x) { if (t < NT_QUP) phase_qup(p, t, lds); else if (t < NT_QUP + NT_KVUP) phase_kvup(p, t - NT_QUP, lds); else phase_ssmS(p, t - NT_QUP - NT_KVUP, lds); }
  GSYNC();
  phase_carry1(p);
  GSYNC();
  phase_carry2(p);
  GSYNC();
  for (int rep = 0; rep < REP_ATTN; ++rep)
  for (int t = blockIdx.x; t < NT_ATTN + NT_SSMY; t += gridDim.x) { if (t < NT_ATTN) attn_item<true>(p, t, lds); else phase_ssmY(p, t - NT_ATTN, lds); }
  GSYNC();
  for (int rep = 0; rep < REP_GLU; ++rep) for (int t = blockIdx.x; t < NT_GLU; t += gridDim.x) phase_glu(p, t, lds);
  GSYNC();
  for (int rep = 0; rep < REP_OUT; ++rep) for (int t = blockIdx.x; t < NT_OUT; t += gridDim.x) phase_out(p, t, lds);
  GSYNC();
  for (int rep = 0; rep < REP_FIN; ++rep) phase_final(p);
}

extern "C" void kernel_launch(void* const* d_in, const int* in_sizes, int n_in, void* d_out, int out_size, void* d_ws, size_t ws_size, hipStream_t stream) {
  P p{};
  const float** f = (const float**)&p;
  for (int i = 0; i < 22; ++i) f[i] = (const float*)d_in[i];
  p.out = (float*)d_out; p.ws = (char*)d_ws;
  if (ws_size < O_END) { fprintf(stderr, "ws too small\n"); return; }
  static int grid_blocks = 0;
  if (!grid_blocks) {
    int dev = 0, cus = 0, per_cu = 0; hipGetDevice(&dev);
    hipDeviceGetAttribute(&cus, hipDeviceAttributeMultiprocessorCount, dev);
    hipOccupancyMaxActiveBlocksPerMultiprocessor(&per_cu, k_mega, 512, 0);
    if (per_cu < 1) per_cu = 1;
    grid_blocks = cus * per_cu;
  }
  hipMemsetAsync((char*)d_ws + O_BAR, 0, 4096 * 4, stream);
  void* args[] = {&p};
  hipError_t e = hipLaunchCooperativeKernel((void*)k_mega, dim3(grid_blocks), dim3(512), args, 0, stream);
  if (e != hipSuccess) fprintf(stderr, "cooperative launch failed: %s (grid %d)\n", hipGetErrorString(e), grid_blocks);
}
```
